# Optimizing an MI355X kernel written in HIP

```python
import math
import jax, jax.numpy as jnp
from jax import lax
import numpy as np

D_MODEL = 1024
BATCH = 16
SEQ = 4096
DEPTH = 1

MIX_WIDTH = D_MODEL
GLA_WIDTH = MIX_WIDTH // 2
GLA_HEADS = 4
GLA_DV = GLA_WIDTH // GLA_HEADS
GLA_DK = GLA_DV // 2
GLA_KEY_WIDTH = GLA_HEADS * GLA_DK
GATE_RANK = 16
GATE_TAU = 16.0
CHUNK = 64
FNET_WIDTH = MIX_WIDTH - GLA_WIDTH
FNET_GROUPS = 4
FNET_GDIM = FNET_WIDTH // FNET_GROUPS
LN_EPS = 1e-5
RMS_EPS = 1e-6
DEEPNORM_ALPHA = (2.0 * DEPTH) ** 0.25
DEEPNORM_BETA = (8.0 * DEPTH) ** -0.25

_SPLITS = [GLA_KEY_WIDTH,
           GLA_KEY_WIDTH,
           GLA_WIDTH,
           GATE_RANK,
           GATE_RANK,
           GLA_WIDTH,
           FNET_WIDTH,
           FNET_WIDTH]
IN_WIDTH = sum(_SPLITS)
_OFFSETS = list(np.cumsum(_SPLITS)[:-1])

kernel_name = "hybrid_gla_fnet_deepnorm_encoder"


def _gla_chunked(q, k, v, log_a):
    B, S, H, DK = q.shape
    DV = v.shape[-1]
    n = S // CHUNK

    def to_chunks(t):
        return t.reshape(B, n, CHUNK, H, t.shape[-1]).transpose(1, 0, 3, 2, 4)

    qc, kc, vc, gc = (to_chunks(t) for t in (q, k, v, log_a))
    bc = jnp.cumsum(gc, axis=3)
    mask = jnp.tril(jnp.ones((CHUNK, CHUNK), dtype=bool))[:, :, None]

    def step(state, inp):
        qi, ki, vi, bi = inp
        b_last = bi[:, :, -1:, :]
        diff = bi[:, :, :, None, :] - bi[:, :, None, :, :]
        decay = jnp.exp(jnp.where(mask, diff, -jnp.inf))
        scores = jnp.einsum('bhid,bhjd,bhijd->bhij', qi, ki, decay)
        o = (jnp.einsum('bhij,bhjv->bhiv', scores, vi)
             + jnp.einsum('bhid,bhdv->bhiv', qi * jnp.exp(bi), state))
        k_dec = ki * jnp.exp(b_last - bi)
        state = (jnp.exp(b_last)[:, :, 0, :, None] * state
                 + jnp.einsum('bhjd,bhjv->bhdv', k_dec, vi))
        return state, o

    state0 = jnp.zeros((B, H, DK, DV), jnp.float32)
    _, o = lax.scan(step, state0, (qc, kc, vc, bc))
    return o.transpose(1, 0, 3, 2, 4).reshape(B, S, H, DV)


def _layernorm(x, g, b):
    xf = x.astype(jnp.float32)
    mu = jnp.mean(xf, axis=-1, keepdims=True)
    var = jnp.mean(jnp.square(xf - mu), axis=-1, keepdims=True)
    y = (xf - mu) * lax.rsqrt(var + LN_EPS) * g.astype(jnp.float32) + b.astype(jnp.float32)
    return y.astype(x.dtype)


def setup_inputs(seed: int = 0) -> dict:
    key = jax.random.key(seed)
    ks = jax.random.split(key, 12)
    x = jax.random.normal(ks[0], (BATCH, SEQ, D_MODEL), jnp.float32)
    w_in = jax.random.normal(ks[1], (DEPTH, D_MODEL, IN_WIDTH), jnp.float32) * D_MODEL ** -0.5
    v0, v1 = 2 * GLA_KEY_WIDTH, 2 * GLA_KEY_WIDTH + GLA_WIDTH
    w_in = w_in.at[:, :, v0:v1].multiply(DEEPNORM_BETA)
    w_gate_up_fwd = jax.random.normal(ks[2], (DEPTH, GATE_RANK, GLA_KEY_WIDTH), jnp.float32) * GATE_RANK ** -0.5
    b_gate_fwd = jax.random.normal(ks[3], (DEPTH, GLA_KEY_WIDTH), jnp.float32) * 0.1
    w_gate_up_bwd = jax.random.normal(ks[4], (DEPTH, GATE_RANK, GLA_KEY_WIDTH), jnp.float32) * GATE_RANK ** -0.5
    b_gate_bwd = jax.random.normal(ks[5], (DEPTH, GLA_KEY_WIDTH), jnp.float32) * 0.1
    gla_norm_g = 1.0 + 0.02 * jax.random.normal(ks[6], (DEPTH, GLA_WIDTH), jnp.float32)
    w_fnet = jax.random.normal(ks[7], (DEPTH, FNET_GROUPS, FNET_GDIM, FNET_GDIM), jnp.float32) * FNET_GDIM ** -0.5
    w_out = jax.random.normal(ks[8], (DEPTH, MIX_WIDTH, D_MODEL), jnp.float32) * (MIX_WIDTH ** -0.5 * DEEPNORM_BETA)
    ln_g = 1.0 + 0.02 * jax.random.normal(ks[9], (DEPTH, D_MODEL), jnp.float32)
    ln_b = 0.02 * jax.random.normal(ks[10], (DEPTH, D_MODEL), jnp.float32)
    return {"x": x, "w_in": w_in, "w_gate_up_fwd": w_gate_up_fwd, "b_gate_fwd": b_gate_fwd,
            "w_gate_up_bwd": w_gate_up_bwd, "b_gate_bwd": b_gate_bwd, "gla_norm_g": gla_norm_g,
            "w_fnet": w_fnet, "w_out": w_out, "ln_g": ln_g, "ln_b": ln_b}


def reference(x, w_in, w_gate_up_fwd, b_gate_fwd, w_gate_up_bwd, b_gate_bwd, gla_norm_g,
              w_fnet, w_out, ln_g, ln_b):
    B, S, _ = x.shape
    f32 = jnp.float32
    for l in range(DEPTH):
        proj = jnp.einsum('bsd,de->bse', x, w_in[l])
        q, k, v, gf_lr, gb_lr, z_gla, u, z_fnet = jnp.split(proj, _OFFSETS, axis=-1)

        qh = (q.astype(f32) * (GLA_DK ** -0.5)).reshape(B, S, GLA_HEADS, GLA_DK)
        kh = k.astype(f32).reshape(B, S, GLA_HEADS, GLA_DK)
        vh = v.astype(f32).reshape(B, S, GLA_HEADS, GLA_DV)
        log_af = jax.nn.log_sigmoid(
            jnp.einsum('bsr,rk->bsk', gf_lr.astype(f32), w_gate_up_fwd[l].astype(f32))
            + b_gate_fwd[l].astype(f32)) / GATE_TAU
        log_ab = jax.nn.log_sigmoid(
            jnp.einsum('bsr,rk->bsk', gb_lr.astype(f32), w_gate_up_bwd[l].astype(f32))
            + b_gate_bwd[l].astype(f32)) / GATE_TAU
        log_af = log_af.reshape(B, S, GLA_HEADS, GLA_DK)
        log_ab = log_ab.reshape(B, S, GLA_HEADS, GLA_DK)
        o_fwd = _gla_chunked(qh, kh, vh, log_af)
        flip = lambda t: jnp.flip(t, axis=1)
        o_bwd = flip(_gla_chunked(flip(qh), flip(kh), flip(vh), flip(log_ab)))
        o = o_fwd + o_bwd
        o = o * lax.rsqrt(jnp.mean(jnp.square(o), axis=-1, keepdims=True) + RMS_EPS)
        o = o.reshape(B, S, GLA_WIDTH) * gla_norm_g[l].astype(f32)
        y_gla = o * jax.nn.silu(z_gla.astype(f32))

        ug = u.astype(f32).reshape(B, S, FNET_GROUPS, FNET_GDIM)
        uf = jnp.fft.fft2(ug, axes=(1, 3), norm='ortho').real.astype(f32)
        uf = jnp.einsum('bsgc,gcd->bsgd', uf, w_fnet[l].astype(f32)).reshape(B, S, FNET_WIDTH)
        y_fnet = uf * jax.nn.silu(z_fnet.astype(f32))

        mix = jnp.concatenate([y_gla, y_fnet], axis=-1).astype(x.dtype)
        y = jnp.einsum('bse,ed->bsd', mix, w_out[l])

        x = _layernorm(DEEPNORM_ALPHA * x + y, ln_g[l], ln_b[l])
    return x
```

```cpp
#include <hip/hip_runtime.h>
#include <cstdio>
#include <cstdint>
namespace pg8 {
#define PG8_LAS __attribute__((address_space(3)))
typedef unsigned short bf16_t;
typedef short bf16x8 __attribute__((ext_vector_type(8)));
typedef float f32x4 __attribute__((ext_vector_type(4)));
typedef unsigned u32x4 __attribute__((ext_vector_type(4)));
constexpr int BM = 256, BK = 64, HALF = 128, HTB = HALF * BK * 2  , STAGE_BYTES = 8 * HTB, NXCD = 8, WGM = 8;

__host__ __device__ __forceinline__ int lds_byte(int r, int c) { const int st = (r >> 4) * 2 + (c >> 5), rr = r & 15, cc = c & 31, ob = rr * 64 + cc * 2; return st * 1024 + (ob ^ (((ob >> 9) & 1) << 5)); }
__host__ __device__ __forceinline__ void stage_rc(int b, int& R, int& C) { const int st = b / 1024, sb = b % 1024, swz = sb ^ (((sb >> 9) & 1) << 5); R = (st >> 1) * 16 + swz / 64; C = (st & 1) * 32 + (swz % 64) / 2; }
__host__ __device__ __forceinline__ int perm32(int rho) { const int n = rho >> 4, i = rho & 15; return 8 * (i >> 2) + 4 * n + (i & 3); }

struct Unit { int pm, pn; };
struct Gemm { const bf16_t* A; const bf16_t* Bt; int M, N, K; };

struct StaticOrder {
    int nM, nN, nwg, G, c;
    __host__ __device__ void init(int M, int N, int G_, int c_) { nM = M / BM; nN = N / BM; nwg = nM * nN; G = G_; c = c_; }
    __host__ __device__ bool next(int i, Unit& u) const {
        const long L = (long)i * G + c; if (L >= nwg) return false;
        int wgid = (int)L; { const int q = nwg / NXCD, r = nwg % NXCD, xcd = wgid % NXCD, off = wgid / NXCD; wgid = (xcd < r ? xcd * (q + 1) : r * (q + 1) + (xcd - r) * q) + off; }
        const int nig = WGM * nN, gid = wgid / nig, fm = gid * WGM, gsz = (nM - fm) < WGM ? (nM - fm) : WGM;
        u.pm = fm + ((wgid % nig) % gsz); u.pn = (wgid % nig) / gsz; return true;
    }
    __device__ __forceinline__ void a_ready(const Unit&) const {}
    __device__ __forceinline__ void done(const Unit&) const {}
};

__device__ __forceinline__ unsigned cvt_pk_bf16(float lo, float hi) { unsigned r; asm volatile("v_cvt_pk_bf16_f32 %0, %1, %2" : "=v"(r) : "v"(lo), "v"(hi)); return r; }
typedef float f32x2 __attribute__((ext_vector_type(2)));
__device__ __forceinline__ f32x2 gelu_pk(f32x2 v) {
    const f32x2 av = __builtin_elementwise_abs(v), d = av * 0.2316418882f + 1.0f;
    f32x2 t; t.x = __builtin_amdgcn_rcpf(d.x); t.y = __builtin_amdgcn_rcpf(d.y);
    f32x2 q = t * 0.5307027145f + (-0.7265760135f); q = q * t + 0.7107068705f; q = q * t + (-0.142248368f); q = q * t + 0.127414796f; q = q * t;
    const f32x2 s = (v * v) * (-0.72134752044f);
    f32x2 e; e.x = __builtin_amdgcn_exp2f(s.x); e.y = __builtin_amdgcn_exp2f(s.y);
    const f32x2 m = v * (q * e), r = v - m;
    f32x2 o; o.x = v.x < 0.f ? m.x : r.x; o.y = v.y < 0.f ? m.y : r.y; return o;
}

template <int ACT  > struct EpiBf16 {
    static constexpr bool PERM = true, AFTER_DRAIN = false; static_assert(ACT == 0 || ACT == 1, "EpiBf16: ACT is 0 (none) or 1 (gelu_pk)");
    bf16_t* O; int ldc; const float* bias; int split_cols; size_t split_stride; float scale0;
    __device__ __forceinline__ void operator()(const f32x4 (&acc)[2][2][4][2], const Unit& u, int wr, int wc, int fr, int fq) const {
        const int row0 = u.pm * BM + wr * 64 + fr; int colt = u.pn * BM; bf16_t* base = O;
        float sc = 1.f; if (split_cols) { const int t = colt / split_cols; base += (size_t)t * split_stride; colt -= t * split_cols; if (t == 0) sc = scale0; }
        const int col0 = colt + wc * 32 + 8 * fq, bcol0 = u.pn * BM + wc * 32 + 8 * fq;
        f32x4 bv[2][2];
#pragma unroll
        for (int bj = 0; bj < 2; ++bj)
#pragma unroll
            for (int n = 0; n < 2; ++n) bv[bj][n] = bias ? *(const f32x4*)(bias + bcol0 + bj * HALF + 4 * n) : (f32x4){0.f, 0.f, 0.f, 0.f};
#pragma unroll
        for (int ai = 0; ai < 2; ++ai)
#pragma unroll
            for (int m = 0; m < 4; ++m) { bf16_t* rowp = base + (size_t)(row0 + ai * HALF + m * 16) * ldc + col0;
#pragma unroll
                for (int bj = 0; bj < 2; ++bj) { f32x4 v0 = acc[ai][bj][m][0] + bv[bj][0], v1 = acc[ai][bj][m][1] + bv[bj][1];
                    if (ACT == 1) { f32x2 a = gelu_pk((f32x2){v0[0], v0[1]}), b = gelu_pk((f32x2){v0[2], v0[3]}), c = gelu_pk((f32x2){v1[0], v1[1]}), d = gelu_pk((f32x2){v1[2], v1[3]});
                        v0 = (f32x4){a.x, a.y, b.x, b.y}; v1 = (f32x4){c.x, c.y, d.x, d.y}; }
                    v0 = v0 * sc; v1 = v1 * sc; u32x4 w; w.x = cvt_pk_bf16(v0[0], v0[1]); w.y = cvt_pk_bf16(v0[2], v0[3]); w.z = cvt_pk_bf16(v1[0], v1[1]); w.w = cvt_pk_bf16(v1[2], v1[3]);
                    *(u32x4*)(rowp + bj * HALF) = w; } }
    }
};

struct PanelStats {
    unsigned* xbuf;
    unsigned* cnt;
    unsigned* tmo;
    int ntn; float eps;
    unsigned code;
    __device__ __forceinline__ bool run(const f32x4 (&v)[2][2][4][2], const Unit& u, int wr, int wc, int fr, int fq, PG8_LAS unsigned char* lds, int wid, int lane) const {
        typedef float f32x2v __attribute__((ext_vector_type(2)));
        PG8_LAS f32x2v* P = (PG8_LAS f32x2v*)lds;
        PG8_LAS f32x2v* S = (PG8_LAS f32x2v*)(lds + 8192);
        PG8_LAS unsigned* flag = (PG8_LAS unsigned*)(lds + 8192 + 2048);
#pragma unroll
        for (int ai = 0; ai < 2; ++ai)
#pragma unroll
            for (int m = 0; m < 4; ++m) {
                float s = 0.f;
#pragma unroll
                for (int bj = 0; bj < 2; ++bj)
#pragma unroll
                    for (int n = 0; n < 2; ++n) { const f32x4 x = v[ai][bj][m][n]; s += (x[0] + x[1]) + (x[2] + x[3]); }
                s += __shfl_xor(s, 16); s += __shfl_xor(s, 32);
                const float mw = s * (1.0f / 64.0f); float q = 0.f;
#pragma unroll
                for (int bj = 0; bj < 2; ++bj)
#pragma unroll
                    for (int n = 0; n < 2; ++n) { const f32x4 d = v[ai][bj][m][n] - mw; q += (d[0] * d[0] + d[1] * d[1]) + (d[2] * d[2] + d[3] * d[3]); }
                q += __shfl_xor(q, 16); q += __shfl_xor(q, 32);
                if (fq == 0) P[(ai * HALF + wr * 64 + m * 16 + fr) * 4 + wc] = (f32x2v){mw, q};
            }
        asm volatile("s_waitcnt lgkmcnt(0)" ::: "memory"); __builtin_amdgcn_s_barrier(); asm volatile("" ::: "memory");
#if defined(BROKEN_EXCHANGE_NO_WAIT)
#warning BROKEN CONTROL BUILD: the row-statistics exchange does not wait; results are wrong by design
        if (blockIdx.x >= 64) { const long long t0_ = clock64(); while (clock64() - t0_ < 60000) __builtin_amdgcn_s_sleep(8); }
#endif
        const int row = wid * 32 + (lane & 31);
        if (lane < 32) {
            const f32x2v a = P[row * 4 + 0], b = P[row * 4 + 1], c = P[row * 4 + 2], d = P[row * 4 + 3];
            const float mt = (a.x + b.x + c.x + d.x) * 0.25f;
            const float da = a.x - mt, db = b.x - mt, dc = c.x - mt, dd = d.x - mt;
            const float m2 = (a.y + b.y) + (c.y + d.y) + 64.0f * ((da * da + db * db) + (dc * dc + dd * dd));
            unsigned long long* slot = (unsigned long long*)xbuf + ((size_t)(u.pm * BM + row) * 4 + u.pn);
            __hip_atomic_store(slot, ((unsigned long long)__float_as_uint(m2) << 32) | __float_as_uint(mt), __ATOMIC_RELAXED, __HIP_MEMORY_SCOPE_AGENT);
        }
        asm volatile("s_waitcnt vmcnt(0)" ::: "memory");
        if (lane == 0) __hip_atomic_fetch_add(cnt + 64 * u.pm, 1u, __ATOMIC_RELAXED, __HIP_MEMORY_SCOPE_AGENT);
        if (wid == 0) {
            bool dead = false; const unsigned long long t0 = __builtin_amdgcn_s_memrealtime(); const unsigned want = 8u * (unsigned)ntn;
            for (;;) {
#if defined(BROKEN_EXCHANGE_NO_WAIT)
                break;
#endif
                if ((unsigned)__builtin_amdgcn_readfirstlane(__hip_atomic_load(cnt + 64 * u.pm, __ATOMIC_RELAXED, __HIP_MEMORY_SCOPE_AGENT)) >= want) break;
                if (__builtin_amdgcn_s_memrealtime() - t0 > 2000000ull) {
                    if (lane == 0) { unsigned expect = 0u; __hip_atomic_compare_exchange_strong(tmo + 1, &expect, code | (unsigned)(u.pm & 0xff), __ATOMIC_RELAXED, __ATOMIC_RELAXED, __HIP_MEMORY_SCOPE_AGENT);
                                     __hip_atomic_store(tmo, 1u, __ATOMIC_RELAXED, __HIP_MEMORY_SCOPE_AGENT); }
                    dead = true; break; }
                __builtin_amdgcn_s_sleep(2);
            }
            __builtin_amdgcn_fence(__ATOMIC_ACQUIRE, "agent");
            if (lane == 0) flag[0] = dead ? 1u : 0u;
        }
        asm volatile("s_waitcnt vmcnt(0) lgkmcnt(0)" ::: "memory"); __builtin_amdgcn_s_barrier(); asm volatile("" ::: "memory");
        const bool bad = flag[0] != 0u;
        if (lane < 32) {
            const unsigned long long* slot = (const unsigned long long*)xbuf + (size_t)(u.pm * BM + row) * 4; float mt[4], m2[4]; float ms = 0.f;
#pragma unroll
            for (int t = 0; t < 4; ++t) { if (t < ntn) { const unsigned long long w = __hip_atomic_load(slot + t, __ATOMIC_RELAXED, __HIP_MEMORY_SCOPE_AGENT); mt[t] = __uint_as_float((unsigned)w); m2[t] = __uint_as_float((unsigned)(w >> 32)); } else { mt[t] = 0.f; m2[t] = 0.f; } ms += mt[t]; }
            const float mean = ms / (float)ntn; float q = 0.f;
#pragma unroll
            for (int t = 0; t < 4; ++t) if (t < ntn) { const float dm = mt[t] - mean; q += m2[t] + 256.0f * dm * dm; }
            S[row] = (f32x2v){mean, 1.0f / sqrtf(q / (256.0f * (float)ntn) + eps)};
        }
        asm volatile("s_waitcnt lgkmcnt(0)" ::: "memory"); __builtin_amdgcn_s_barrier(); asm volatile("" ::: "memory");
        return bad;
    }
};
struct EpiLnRes {
    static constexpr bool PERM = false, AFTER_DRAIN = true;
    const float* base; float* out; int ldc; const float* bias; PanelStats st; unsigned poison;
    __device__ __forceinline__ void fused(f32x4 (&acc)[2][2][4][2], const Unit& u, int wr, int wc, int fr, int fq, PG8_LAS unsigned char* lds, int wid, int lane) const {
        typedef float f32x2v __attribute__((ext_vector_type(2)));
        const PG8_LAS f32x2v* S = (const PG8_LAS f32x2v*)(lds + 8192);
        const int col0 = u.pn * BM + wc * 32 + 4 * fq;
#pragma unroll
        for (int bj = 0; bj < 2; ++bj)
#pragma unroll
            for (int n = 0; n < 2; ++n) { const f32x4 bv = bias ? *(const f32x4*)(bias + col0 + bj * HALF + n * 16) : (f32x4){0.f, 0.f, 0.f, 0.f};
#pragma unroll
                for (int ai = 0; ai < 2; ++ai)
#pragma unroll
                    for (int m = 0; m < 4; ++m) acc[ai][bj][m][n] += bv; }
        f32x4 pre[4][2][2];
#pragma unroll
        for (int m = 0; m < 4; ++m) { const size_t off = (size_t)(u.pm * BM + wr * 64 + m * 16 + fr) * ldc + col0;
#pragma unroll
            for (int bj = 0; bj < 2; ++bj)
#pragma unroll
                for (int n = 0; n < 2; ++n) pre[m][bj][n] = *(const f32x4*)(base + off + bj * HALF + n * 16); }
        const bool bad = st.run(acc, u, wr, wc, fr, fq, lds, wid, lane) || poison != 0u;
        const float qnan = __builtin_nanf("");
#pragma unroll
        for (int ai = 0; ai < 2; ++ai)
#pragma unroll
            for (int m = 0; m < 4; ++m) { const int r = ai * HALF + wr * 64 + m * 16 + fr; const f32x2v sr = S[r]; const size_t off = (size_t)(u.pm * BM + r) * ldc + col0;
#pragma unroll
                for (int bj = 0; bj < 2; ++bj)
#pragma unroll
                    for (int n = 0; n < 2; ++n) { const f32x4 bs = ai == 0 ? pre[m][bj][n] : *(const f32x4*)(base + off + bj * HALF + n * 16); f32x4 o = bs + (acc[ai][bj][m][n] - sr.x) * sr.y;
                        if (bad) o = (f32x4){qnan, qnan, qnan, qnan}; *(f32x4*)(out + off + bj * HALF + n * 16) = o; }
                if (m & 1) asm volatile("" ::: "memory"); }
    }
};
struct EpiLnResLn {
    static constexpr bool PERM = false, AFTER_DRAIN = true;
    const float* base; float* out; bf16_t* xn; int ldc; const float* bias; PanelStats st1, st2; unsigned poison;
    __device__ __forceinline__ void fused(f32x4 (&acc)[2][2][4][2], const Unit& u, int wr, int wc, int fr, int fq, PG8_LAS unsigned char* lds, int wid, int lane) const {
        typedef float f32x2v __attribute__((ext_vector_type(2))); typedef unsigned u32x2v __attribute__((ext_vector_type(2)));
        const PG8_LAS f32x2v* S = (const PG8_LAS f32x2v*)(lds + 8192);
        const int col0 = u.pn * BM + wc * 32 + 4 * fq;
#pragma unroll
        for (int bj = 0; bj < 2; ++bj)
#pragma unroll
            for (int n = 0; n < 2; ++n) { const f32x4 bv = bias ? *(const f32x4*)(bias + col0 + bj * HALF + n * 16) : (f32x4){0.f, 0.f, 0.f, 0.f};
#pragma unroll
                for (int ai = 0; ai < 2; ++ai)
#pragma unroll
                    for (int m = 0; m < 4; ++m) acc[ai][bj][m][n] += bv; }
        bool bad = st1.run(acc, u, wr, wc, fr, fq, lds, wid, lane) || poison != 0u;
        const float qnan = __builtin_nanf("");
#pragma unroll
        for (int ai = 0; ai < 2; ++ai)
#pragma unroll
            for (int m = 0; m < 4; ++m) { const int r = ai * HALF + wr * 64 + m * 16 + fr; const f32x2v sr = S[r]; const size_t off = (size_t)(u.pm * BM + r) * ldc + col0;
#pragma unroll
                for (int bj = 0; bj < 2; ++bj)
#pragma unroll
                    for (int n = 0; n < 2; ++n) { const f32x4 bs = *(const f32x4*)(base + off + bj * HALF + n * 16); acc[ai][bj][m][n] = bs + (acc[ai][bj][m][n] - sr.x) * sr.y; }
                asm volatile("" : "+v"(acc[ai][0][m][0]), "+v"(acc[ai][0][m][1]), "+v"(acc[ai][1][m][0]), "+v"(acc[ai][1][m][1]));
                if (m & 1) asm volatile("" ::: "memory"); }
        const bool bad1 = bad;
        bad = st2.run(acc, u, wr, wc, fr, fq, lds, wid, lane) || bad;
#pragma unroll
        for (int ai = 0; ai < 2; ++ai)
#pragma unroll
            for (int m = 0; m < 4; ++m) { const int r = ai * HALF + wr * 64 + m * 16 + fr; const f32x2v sr = S[r]; const size_t off = (size_t)(u.pm * BM + r) * ldc + col0;
#pragma unroll
                for (int bj = 0; bj < 2; ++bj)
#pragma unroll
                    for (int n = 0; n < 2; ++n) { const f32x4 x1 = acc[ai][bj][m][n]; *(f32x4*)(out + off + bj * HALF + n * 16) = bad1 ? (f32x4){qnan, qnan, qnan, qnan} : x1;
                        const f32x4 o = (x1 - sr.x) * sr.y; u32x2v w; w.x = cvt_pk_bf16(o[0], o[1]); w.y = cvt_pk_bf16(o[2], o[3]);
                        if (bad) { w.x = 0x7fc07fc0u; w.y = 0x7fc07fc0u; } *(u32x2v*)(xn + off + bj * HALF + n * 16) = w; }
                asm volatile("" ::: "memory"); }
    }
};


struct EpiResF32 {
    static constexpr bool PERM = false, AFTER_DRAIN = false;
    const float* base; float* out; int ldc; float alpha;
    __device__ __forceinline__ void operator()(const f32x4 (&acc)[2][2][4][2], const Unit& u, int wr, int wc, int fr, int fq) const {
        const int col0 = u.pn * BM + wc * 32 + 4 * fq;
#pragma unroll
        for (int ai = 0; ai < 2; ++ai)
#pragma unroll
            for (int m = 0; m < 4; ++m) { const size_t off = (size_t)(u.pm * BM + ai * HALF + wr * 64 + m * 16 + fr) * ldc + col0;
#pragma unroll
                for (int bj = 0; bj < 2; ++bj)
#pragma unroll
                    for (int n = 0; n < 2; ++n) { const f32x4 bs = *(const f32x4*)(base + off + bj * HALF + n * 16); *(f32x4*)(out + off + bj * HALF + n * 16) = bs * alpha + acc[ai][bj][m][n]; }
                if (m & 1) asm volatile("" ::: "memory"); }
    }
};
template <class Epi, class Sched, bool ALIGN_EPI = false, bool SP2 = false>
__device__ __forceinline__ void gemm_phase(PG8_LAS unsigned char* lds, const Gemm g, const Sched& S, const Epi& E) {
    const int tid = threadIdx.x, wid = __builtin_amdgcn_readfirstlane(tid >> 6), lane = tid & 63, wr = wid >> 2, wc = wid & 3, fr = lane & 15, fq = lane >> 4;
    const int K = g.K, nt = K / BK;
    unsigned voffA[2], voffB[2];
#pragma unroll
    for (int i = 0; i < 2; ++i) { int R, C; stage_rc(tid * 16 + i * 8192, R, C); const int Rb = Epi::PERM ? ((R & ~31) + perm32(R & 31)) : R;
        voffA[i] = (unsigned)(R * K + C) * 2u; voffB[i] = (unsigned)(Rb * K + C) * 2u; }
    const size_t kstep = (size_t)(BK * 2);
    const size_t hstep = (size_t)HALF * K * 2;
    const size_t tstep = 2 * hstep;
    const unsigned ldsw = (unsigned)wid * 1024u;
    const int aoff = lds_byte(wr * 64 + fr, fq * 8), boff = lds_byte(wc * 32 + fr, fq * 8);
#define PG8_SA(b, h) (((b) * 2 + (h)) * HTB)
#define PG8_SB(b, h) ((4 + (b) * 2 + (h)) * HTB)
#define PG8_STAGE(bufoff, gbase, voff) do { _Pragma("unroll") for (int _i = 0; _i < 2; ++_i) \
        __builtin_amdgcn_global_load_lds((const unsigned*)((const char*)(gbase) + (voff)[_i]), (PG8_LAS unsigned*)(lds + (bufoff) + ldsw + _i * 8192), 16, 0, 0); } while (0)
#define PG8_LDA(dst, b, h) do { _Pragma("unroll") for (int m = 0; m < 4; ++m) _Pragma("unroll") for (int k = 0; k < 2; ++k) dst[m][k] = *(const PG8_LAS bf16x8*)(lds + PG8_SA(b, h) + aoff + m * 2048 + k * 1024); } while (0)
#define PG8_LDB(dst, b, h) do { _Pragma("unroll") for (int n = 0; n < 2; ++n) _Pragma("unroll") for (int k = 0; k < 2; ++k) dst[n][k] = *(const PG8_LAS bf16x8*)(lds + PG8_SB(b, h) + boff + n * 2048 + k * 1024); } while (0)
#define PG8_MMA(ai, bj, At, Bt) do { __builtin_amdgcn_s_setprio(1); _Pragma("unroll") for (int m = 0; m < 4; ++m) _Pragma("unroll") for (int n = 0; n < 2; ++n) _Pragma("unroll") for (int k = 0; k < 2; ++k) \
        acc[ai][bj][m][n] = __builtin_amdgcn_mfma_f32_16x16x32_bf16(Bt[n][k], At[m][k], acc[ai][bj][m][n], 0, 0, 0); __builtin_amdgcn_s_setprio(0); } while (0)
#define PG8_WAIT_V(n) asm volatile("s_waitcnt vmcnt(" #n ")" ::: "memory")
#define PG8_WAIT_L(n) asm volatile("s_waitcnt lgkmcnt(" #n ")" ::: "memory")
#define PG8_BAR __builtin_amdgcn_s_barrier()
#define PG8_SCHED __builtin_amdgcn_sched_barrier(0)
    Unit cur, nxt; int ui = 0;
    if (!S.next(0, cur)) return;
    f32x4 acc[2][2][4][2];
#pragma unroll
    for (int a = 0; a < 2; ++a)
#pragma unroll
        for (int b = 0; b < 2; ++b)
#pragma unroll
            for (int m = 0; m < 4; ++m)
#pragma unroll
                for (int n = 0; n < 2; ++n) acc[a][b][m][n] = (f32x4){0.f, 0.f, 0.f, 0.f};
    bf16x8 At[4][2], B0[2][2], B1[2][2];
    const char* cA = (const char*)g.A + (size_t)cur.pm * tstep; const char* cB = (const char*)g.Bt + (size_t)cur.pn * tstep;
    S.a_ready(cur);
    if constexpr (SP2) {
        PG8_STAGE(PG8_SB(0, 0), cB, voffB); PG8_STAGE(PG8_SB(0, 1), cB + hstep, voffB); PG8_STAGE(PG8_SA(0, 0), cA, voffA); PG8_STAGE(PG8_SA(0, 1), cA + hstep, voffA);
        if (wr == 1) PG8_BAR;
        PG8_WAIT_V(2); PG8_BAR;
        PG8_STAGE(PG8_SB(1, 0), cB + kstep, voffB); PG8_STAGE(PG8_SA(1, 0), cA + kstep, voffA); PG8_STAGE(PG8_SB(1, 1), cB + hstep + kstep, voffB);
        PG8_WAIT_V(6); PG8_BAR;
    } else {
        PG8_STAGE(PG8_SB(0, 0), cB, voffB); PG8_STAGE(PG8_SA(0, 0), cA, voffA); PG8_STAGE(PG8_SB(0, 1), cB + hstep, voffB); PG8_STAGE(PG8_SA(0, 1), cA + hstep, voffA);
        if (wr == 1) PG8_BAR;
        PG8_WAIT_V(4); PG8_BAR;
        PG8_STAGE(PG8_SB(1, 0), cB + kstep, voffB); PG8_STAGE(PG8_SA(1, 0), cA + kstep, voffA); PG8_STAGE(PG8_SB(1, 1), cB + hstep + kstep, voffB);
        PG8_WAIT_V(6); PG8_BAR;
    }
    for (;;) {
        const bool has_next = S.next(ui + 1, nxt);
        const char* nA = has_next ? (const char*)g.A + (size_t)nxt.pm * tstep : cA; const char* nB = has_next ? (const char*)g.Bt + (size_t)nxt.pn * tstep : cB;
        for (int t = 0; t < nt; t += 2) {
            const bool last = (t == nt - 2);
            const char* a1 = cA + (size_t)(t + 1) * kstep;
            const char* a2 = last ? nA : cA + (size_t)(t + 2) * kstep; const char* b2 = last ? nB : cB + (size_t)(t + 2) * kstep;
            const char* a3 = a2 + kstep; const char* b3 = b2 + kstep;
            if (last && has_next) S.a_ready(nxt);
            if constexpr (SP2) {
            PG8_LDB(B0, 0, 0); PG8_LDB(B1, 0, 1); PG8_SCHED; PG8_LDA(At, 0, 0); PG8_STAGE(PG8_SA(1, 1), a1 + hstep, voffA);
            PG8_WAIT_V(8); PG8_WAIT_L(0); PG8_BAR; PG8_MMA(0, 0, At, B0); PG8_MMA(0, 1, At, B1); PG8_BAR; PG8_SCHED;
            PG8_LDA(At, 0, 1); PG8_STAGE(PG8_SB(0, 0), b2, voffB); PG8_STAGE(PG8_SB(0, 1), b2 + hstep, voffB); PG8_STAGE(PG8_SA(0, 0), a2, voffA);
            PG8_WAIT_V(8); PG8_WAIT_L(0); PG8_BAR; PG8_MMA(1, 0, At, B0); PG8_MMA(1, 1, At, B1); PG8_BAR; PG8_SCHED;
            PG8_LDB(B0, 1, 0); PG8_LDB(B1, 1, 1); PG8_SCHED; PG8_LDA(At, 1, 0); PG8_STAGE(PG8_SA(0, 1), a2 + hstep, voffA);
            PG8_WAIT_V(8); PG8_WAIT_L(0); PG8_BAR; PG8_MMA(0, 0, At, B0); PG8_MMA(0, 1, At, B1); PG8_BAR; PG8_SCHED;
            PG8_LDA(At, 1, 1); PG8_STAGE(PG8_SB(1, 0), b3, voffB); PG8_STAGE(PG8_SB(1, 1), b3 + hstep, voffB); PG8_STAGE(PG8_SA(1, 0), a3, voffA);
            PG8_WAIT_V(8); PG8_WAIT_L(0); PG8_BAR; PG8_MMA(1, 0, At, B0); PG8_MMA(1, 1, At, B1); PG8_BAR; PG8_SCHED;
            } else {
            PG8_LDB(B0, 0, 0); PG8_SCHED; PG8_LDA(At, 0, 0); PG8_STAGE(PG8_SA(1, 1), a1 + hstep, voffA);
            PG8_WAIT_L(8); PG8_BAR; PG8_WAIT_L(0); PG8_MMA(0, 0, At, B0); PG8_BAR; PG8_SCHED;
            PG8_LDB(B1, 0, 1); PG8_STAGE(PG8_SB(0, 0), b2, voffB);
            PG8_BAR; PG8_WAIT_L(0); PG8_MMA(0, 1, At, B1); PG8_BAR;
            PG8_LDA(At, 0, 1); PG8_STAGE(PG8_SA(0, 0), a2, voffA);
            PG8_BAR; PG8_WAIT_L(0); PG8_MMA(1, 0, At, B0); PG8_BAR; PG8_SCHED;
            PG8_STAGE(PG8_SB(0, 1), b2 + hstep, voffB);
            PG8_WAIT_V(6); PG8_BAR; PG8_MMA(1, 1, At, B1); PG8_BAR;
            PG8_LDB(B0, 1, 0); PG8_SCHED; PG8_LDA(At, 1, 0); PG8_STAGE(PG8_SA(0, 1), a2 + hstep, voffA);
            PG8_WAIT_L(8); PG8_BAR; PG8_WAIT_L(0); PG8_MMA(0, 0, At, B0); PG8_BAR; PG8_SCHED;
            PG8_LDB(B1, 1, 1); PG8_STAGE(PG8_SB(1, 0), b3, voffB);
            PG8_BAR; PG8_WAIT_L(0); PG8_MMA(0, 1, At, B1); PG8_BAR;
            PG8_LDA(At, 1, 1); PG8_STAGE(PG8_SA(1, 0), a3, voffA);
            PG8_BAR; PG8_WAIT_L(0); PG8_MMA(1, 0, At, B0); PG8_BAR; PG8_SCHED;
            PG8_STAGE(PG8_SB(1, 1), b3 + hstep, voffB);
            PG8_WAIT_V(6); PG8_BAR; PG8_MMA(1, 1, At, B1); PG8_BAR;
            }
        }
        if constexpr (ALIGN_EPI) { if (wr == 0) PG8_BAR; }
        if constexpr (!Epi::AFTER_DRAIN) { E(acc, cur, wr, wc, fr, fq); S.done(cur); }
        if (!has_next) break;
#pragma unroll
        for (int a = 0; a < 2; ++a)
#pragma unroll
            for (int b = 0; b < 2; ++b)
#pragma unroll
                for (int m = 0; m < 4; ++m)
#pragma unroll
                    for (int n = 0; n < 2; ++n) acc[a][b][m][n] = (f32x4){0.f, 0.f, 0.f, 0.f};
        cur = nxt; cA = nA; cB = nB; ++ui;
        if constexpr (ALIGN_EPI) { if (wr == 1) PG8_BAR; }
    }
    PG8_WAIT_V(0);
    if constexpr (!ALIGN_EPI) { if (wr == 0) PG8_BAR; }
    PG8_BAR;
    if constexpr (Epi::AFTER_DRAIN) { E.fused(acc, cur, wr, wc, fr, fq, lds, wid, lane); S.done(cur); }
#undef PG8_SA
#undef PG8_SB
#undef PG8_STAGE
#undef PG8_LDA
#undef PG8_LDB
#undef PG8_MMA
#undef PG8_WAIT_V
#undef PG8_WAIT_L
#undef PG8_BAR
#undef PG8_SCHED
}
}

#define GAS __attribute__((address_space(1)))
#define LAS __attribute__((address_space(3)))
typedef unsigned short bf16;
typedef unsigned v4u __attribute__((ext_vector_type(4)));
typedef float f32x4 __attribute__((ext_vector_type(4)));
typedef short bf16x8 __attribute__((ext_vector_type(8)));
typedef GAS unsigned gu32;
typedef GAS unsigned long long gu64;
#define RLX_AGENT __ATOMIC_RELAXED, __HIP_MEMORY_SCOPE_AGENT
#define LDS_WAIT() asm volatile("s_waitcnt lgkmcnt(0)" ::: "memory")
#define VM_WAIT() asm volatile("s_waitcnt vmcnt(0)" ::: "memory")
__device__ __forceinline__ unsigned long long rt() { return __builtin_amdgcn_s_memrealtime(); }
__device__ __forceinline__ unsigned f2bf(float f) { unsigned u = __builtin_bit_cast(unsigned, f); return (u + 0x7fffu + ((u >> 16) & 1u)) >> 16; }
__device__ __forceinline__ unsigned pk2(float lo, float hi) { return f2bf(lo) | (f2bf(hi) << 16); }

#define XB_TMO      128
#define XB_XCNT(j)  (256  + 64 * (j))
#define XB_XSUB(j)  (1280 + 64 * (j))
#define XB_XGEN(j)  (2304 + 64 * (j))
#define XB_TOP      3328
#define XB_TOPGEN   3392
#define XCD_BAR_WORDS 3456
#define XB_SPIN_CAP (1u << 18)

__device__ __forceinline__ unsigned xb_ld(unsigned* p)              { return __hip_atomic_load(p, __ATOMIC_RELAXED, __HIP_MEMORY_SCOPE_AGENT); }
__device__ __forceinline__ unsigned xb_add(unsigned* p, unsigned v) { return __hip_atomic_fetch_add(p, v, __ATOMIC_RELAXED, __HIP_MEMORY_SCOPE_AGENT); }
__device__ __forceinline__ unsigned xb_xcc_id() { return (unsigned)__builtin_amdgcn_s_getreg((3 << 11) | 20) & 0xFu; }
#define XB_SPIN(cond, bar) do { unsigned _sp = 0; while (cond) { __builtin_amdgcn_s_sleep(1); \
    if ((++_sp & 255u) == 0u) { if (xb_ld(&(bar)[XB_TMO])) break; if (_sp > XB_SPIN_CAP) { atomicAdd(&(bar)[XB_TMO], 1u); break; } } } } while (0)

struct XcdBarrier {
    unsigned* bar; unsigned x;
    volatile LAS unsigned* st;
};

__device__ __forceinline__ XcdBarrier xcd_barrier_post(unsigned* bar, volatile LAS unsigned* st) {
    XcdBarrier b; b.bar = bar; b.x = xb_xcc_id(); b.st = st;
    if (threadIdx.x == 0) (void)xb_add(&bar[XB_XCNT(b.x)], 1u);
    return b;
}
__device__ __forceinline__ void xcd_barrier_complete(unsigned* bar, unsigned x, unsigned& nloc, unsigned& nx) {
    const unsigned G = gridDim.x * gridDim.y * gridDim.z;
    unsigned sum, cnt, mine, sp = 0u;
    for (;;) {
        sum = 0u; cnt = 0u; mine = 0u;
#pragma unroll
        for (unsigned j = 0; j < 16; ++j) { const unsigned c = xb_ld(&bar[XB_XCNT(j)]); sum += c; cnt += (c > 0u) ? 1u : 0u; mine = (j == x) ? c : mine; }
        if (sum == G) break;
        __builtin_amdgcn_s_sleep(1);
        if ((++sp & 255u) == 0u) { if (xb_ld(&bar[XB_TMO])) break; if (sp > XB_SPIN_CAP) { atomicAdd(&bar[XB_TMO], 1u); break; } }
    }
    nloc = mine > 0u ? mine : 1u; nx = cnt > 0u ? cnt : 1u;
}

__device__ __forceinline__ void xcd_barrier(const XcdBarrier& b) {
    asm volatile("s_waitcnt vmcnt(0)" ::: "memory");
    __syncthreads();
    if (threadIdx.x == 0) {
        unsigned* bar = b.bar;
        __builtin_amdgcn_s_waitcnt(0);
        unsigned nloc = b.st[0], nx = b.st[1];
        if (nloc == 0u) { xcd_barrier_complete(bar, b.x, nloc, nx); b.st[0] = nloc; b.st[1] = nx; }
        const unsigned old = xb_add(&bar[XB_XSUB(b.x)], 1u);
        const unsigned gen = old / nloc;
        if (old + 1u == (gen + 1u) * nloc) {
            __builtin_amdgcn_fence(__ATOMIC_RELEASE, "agent");
            asm volatile("s_waitcnt vmcnt(0)" ::: "memory");
            const unsigned og = xb_add(&bar[XB_TOP], 1u);
            const unsigned tg = og / nx;
            if (og + 1u == (tg + 1u) * nx) xb_add(&bar[XB_TOPGEN], 1u);
            else XB_SPIN(xb_ld(&bar[XB_TOPGEN]) == tg, bar);
            __builtin_amdgcn_fence(__ATOMIC_ACQUIRE, "agent");
            xb_add(&bar[XB_XGEN(b.x)], 1u);
            asm volatile("s_waitcnt vmcnt(0)" ::: "memory");
        } else {
            XB_SPIN(xb_ld(&bar[XB_XGEN(b.x)]) == gen, bar);
            __builtin_amdgcn_fence(__ATOMIC_ACQUIRE, "agent");
            asm volatile("s_waitcnt vmcnt(0)" ::: "memory");
        }
    }
    __syncthreads();
}

constexpr int NWAVES = 8;
constexpr int BATCH = 16, SEQ = 4096, DM = 1024, M = BATCH * SEQ;
constexpr int NPROJ = 2592, NPAD = 2816;
constexpr int C_Q = 0, C_K = 256, C_V = 512, C_ZG = 1024, C_U = 1536, C_ZF = 2048, C_GF = 2560, C_GB = 2576;
constexpr float LN_EPS = 1e-5f, RMS_EPS = 1e-6f;
constexpr float DN_ALPHA = 1.189207115002721f;
constexpr float FN_SCALE = 0.0013810679320049757f;

constexpr size_t MiB = 1u << 20;
constexpr size_t WS_CTL = 0, CTL_ZERO_BYTES = 1 * MiB;
constexpr size_t WS_WIN = 2 * MiB;
constexpr size_t WS_WOUT = 8 * MiB;
constexpr size_t WS_CW = 10 * MiB;
constexpr size_t WS_XB = 16 * MiB;
constexpr size_t WS_PR = 144 * MiB;
constexpr size_t WS_MIX = 496 * MiB;
constexpr size_t WS_AP = 624 * MiB, WS_BP = 688 * MiB;
constexpr size_t WS_YR = 752 * MiB, WS_YI = 816 * MiB;
constexpr size_t WS_OF = 880 * MiB, WS_OB = 944 * MiB;
constexpr size_t WS_END = 1008 * MiB;
constexpr int CW_TMO = 0, CW_CODE = 1, CW_BAR = 4096;

constexpr int RING_BYTES = 131072, LDSCTL_OFF = RING_BYTES, MISC_OFF = LDSCTL_OFF + 320, LDS_BYTES = 147456;

__device__ __forceinline__ float bf2f(unsigned short h) { return __uint_as_float((unsigned)h << 16); }
__device__ __forceinline__ float wave_sum(float v) {
#pragma unroll
    for (int o = 1; o < 64; o <<= 1) v += __shfl_xor(v, o);
    return v;
}
__device__ __forceinline__ float silu_f(float z) { return z / (1.f + __expf(-z)); }

struct Frame {
    LAS unsigned char* lds;
    volatile LAS unsigned* MISC;
    gu32* ctl;
    int tid, lane, wave, G;
    const float *x, *w_in, *wgu_f, *bg_f, *wgu_b, *bg_b, *gng, *w_fnet, *w_out, *ln_g, *ln_b;
    float* out;
    bf16 *WIN, *WOUT, *XB, *PR, *MIX, *AP, *BP, *YR, *YI, *OF, *OB;
    float *CW, *SW;
};

__device__ __forceinline__ void p0_transpose_item(const float* W, int K, int N, bf16* WT, int k0, int n0, int drow0, float sc, LAS float* scr, int lane) {
#pragma unroll 8
    for (int i = 0; i < 32; ++i) { const int kk = 2 * i + (lane >> 5); scr[kk * 33 + (lane & 31)] = W[(size_t)(k0 + kk) * N + n0 + (lane & 31)] * sc; }
    LDS_WAIT(); asm volatile("" ::: "memory");
    const int c = lane & 7;
#pragma unroll
    for (int j = 0; j < 4; ++j) { const int n = (lane >> 3) + 8 * j; const LAS float* s = scr + (8 * c) * 33 + n;
        v4u o; o.x = pk2(s[0 * 33], s[1 * 33]); o.y = pk2(s[2 * 33], s[3 * 33]); o.z = pk2(s[4 * 33], s[5 * 33]); o.w = pk2(s[6 * 33], s[7 * 33]);
        *(GAS v4u*)(WT + (size_t)(drow0 + n) * K + k0 + 8 * c) = o; }
    LDS_WAIT(); asm volatile("" ::: "memory");
}

__device__ __forceinline__ void ph_prep(Frame& F) {
    LAS float* scr = (LAS float*)(F.lds + F.wave * 16384);
    const int gw = blockIdx.x * NWAVES + F.wave, NGW = F.G * NWAVES;
    constexpr int NB_IN = NPROJ / 32, I_IN = (DM / 64) * NB_IN, I_OUT = (DM / 64) * (DM / 32);
    for (int it = gw; it < I_IN + I_OUT; it += NGW) {
        if (it < I_IN) {
            const int kb = it / NB_IN, nb = it % NB_IN, n0 = nb * 32;
            const int drow0 = (n0 < 1024) ? n0 : (n0 == 1024 ? C_GF : n0 - 32);
            p0_transpose_item(F.w_in, DM, NPROJ, F.WIN, kb * 64, n0, drow0, (n0 < 256) ? 0.125f : 1.f, scr, F.lane);
        } else {
            const int r = it - I_IN, kb = r / (DM / 32), nb = r % (DM / 32);
            p0_transpose_item(F.w_out, DM, DM, F.WOUT, kb * 64, nb * 32, nb * 32, 1.f, scr, F.lane);
        }
    }
    const int gt = blockIdx.x * (NWAVES * 64) + F.tid, NGT = F.G * NWAVES * 64;
    for (int i = gt; i < (NPAD - NPROJ) * DM / 8; i += NGT) ((GAS v4u*)(F.WIN + (size_t)NPROJ * DM))[i] = (v4u){0u, 0u, 0u, 0u};
    for (size_t i = gt; i < (size_t)M * DM / 8; i += NGT) {
        const f32x4 a = ((const GAS f32x4*)F.x)[2 * i], b = ((const GAS f32x4*)F.x)[2 * i + 1];
        v4u o; o.x = pk2(a.x, a.y); o.y = pk2(a.z, a.w); o.z = pk2(b.x, b.y); o.w = pk2(b.z, b.w);
        ((GAS v4u*)F.XB)[i] = o;
    }
    for (int i = gt; i < 4 * 128 * 128; i += NGT) {
        const int d = i & 127, c = (i >> 7) & 127, g = i >> 14;
        float sc_ = 0.f, ss_ = 0.f;
        for (int k = 0; k < 128; ++k) { float sn, cs; sincospif((float)((c * k) & 127) * (1.f / 64.f), &sn, &cs); const float w = F.w_fnet[(g * 128 + k) * 128 + d]; sc_ += cs * w; ss_ += sn * w; }
        F.CW[i] = sc_; F.SW[i] = ss_;
    }
}

__device__ __forceinline__ void ph_t1(Frame& F) {
    float* us = (float*)(unsigned char*)F.lds;
    const int tid = F.tid, d = tid & 127, rq = tid >> 7;
    for (int it = blockIdx.x; it < (M / 32) * 4; it += F.G) {
        const int g = it & 3, row0 = (it >> 2) * 32;
        { const int r = tid >> 4, sg = tid & 15;
          const v4u raw = *(const GAS v4u*)(F.PR + (size_t)(row0 + r) * NPAD + C_U + g * 128 + sg * 8);
          float* o = us + r * 128 + sg * 8;
          o[0] = __uint_as_float(raw.x << 16); o[1] = __uint_as_float(raw.x & 0xffff0000u); o[2] = __uint_as_float(raw.y << 16); o[3] = __uint_as_float(raw.y & 0xffff0000u);
          o[4] = __uint_as_float(raw.z << 16); o[5] = __uint_as_float(raw.z & 0xffff0000u); o[6] = __uint_as_float(raw.w << 16); o[7] = __uint_as_float(raw.w & 0xffff0000u); }
        __syncthreads();
        float aA[8], aB[8];
#pragma unroll
        for (int r = 0; r < 8; ++r) { aA[r] = 0.f; aB[r] = 0.f; }
        const float* cw = F.CW + g * 16384 + d; const float* sw = F.SW + g * 16384 + d;
        for (int c = 0; c < 128; ++c) { const float w1 = cw[c * 128], w2 = sw[c * 128];
#pragma unroll
            for (int r = 0; r < 8; ++r) { const float uu = us[(rq * 8 + r) * 128 + c]; aA[r] += uu * w1; aB[r] += uu * w2; } }
#pragma unroll
        for (int r = 0; r < 8; ++r) { const size_t o = (size_t)(row0 + rq * 8 + r) * 512 + g * 128 + d; F.AP[o] = (bf16)f2bf(aA[r]); F.BP[o] = (bf16)f2bf(aB[r]); }
        __syncthreads();
    }
}

__device__ __forceinline__ void ph_s1(Frame& F) {
    float* cs = (float*)(unsigned char*)F.lds; float* sn = cs + 64;
    if (F.tid < 64) { float s, c; sincospif((float)F.tid * (1.f / 32.f), &s, &c); cs[F.tid] = c; sn[F.tid] = s; }
    __syncthreads();
    const int col = F.tid;
    for (int it = blockIdx.x; it < BATCH * 64; it += F.G) {
        const int b = it >> 6, n2 = it & 63;
        float za[64], zb[64];
#pragma unroll
        for (int n1 = 0; n1 < 64; ++n1) { const size_t o = (size_t)(b * SEQ + 64 * n1 + n2) * 512 + col; za[n1] = bf2f(F.AP[o]); zb[n1] = bf2f(F.BP[o]); }
        for (int k1 = 0; k1 < 64; ++k1) {
            float yr = 0.f, yi = 0.f;
#pragma unroll
            for (int n1 = 0; n1 < 64; ++n1) { const int ix = (k1 * n1) & 63; const float c = cs[ix], s = sn[ix]; yr += za[n1] * c - zb[n1] * s; yi -= zb[n1] * c + za[n1] * s; }
            float ts, tc; sincospif((float)(n2 * k1) * (1.f / 2048.f), &ts, &tc);
            const float pr = yr * tc + yi * ts, pi = yi * tc - yr * ts;
            const size_t o = (size_t)(b * SEQ + k1 * 64 + n2) * 512 + col; F.YR[o] = (bf16)f2bf(pr); F.YI[o] = (bf16)f2bf(pi);
        }
    }
}

__device__ __forceinline__ void ph_s2(Frame& F) {
    float* cs = (float*)(unsigned char*)F.lds; float* sn = cs + 64;
    if (F.tid < 64) { float s, c; sincospif((float)F.tid * (1.f / 32.f), &s, &c); cs[F.tid] = c; sn[F.tid] = s; }
    __syncthreads();
    const int col = F.tid;
    for (int it = blockIdx.x; it < BATCH * 64; it += F.G) {
        const int b = it >> 6, k1 = it & 63;
        float yr[64], yi[64];
#pragma unroll
        for (int n2 = 0; n2 < 64; ++n2) { const size_t o = (size_t)(b * SEQ + k1 * 64 + n2) * 512 + col; yr[n2] = bf2f(F.YR[o]); yi[n2] = bf2f(F.YI[o]); }
        for (int k2 = 0; k2 < 64; ++k2) {
            float x = 0.f;
#pragma unroll
            for (int n2 = 0; n2 < 64; ++n2) { const int ix = (k2 * n2) & 63; x += yr[n2] * cs[ix] + yi[n2] * sn[ix]; }
            const size_t row = (size_t)(b * SEQ + k1 + 64 * k2);
            const float z = bf2f(F.PR[row * NPAD + C_ZF + col]);
            F.MIX[row * DM + 512 + col] = (bf16)f2bf(x * FN_SCALE * silu_f(z));
        }
    }
}

__device__ __forceinline__ void ph_gla_naive(Frame& F) {
    float* L = (float*)(unsigned char*)F.lds;
    float* wup = L;
    float* bia = wup + 1024;
    float* qs = bia + 64;
    float* ks = qs + 4096;
    float* as = ks + 4096;
    float* vs = as + 4096;
    float* part = vs + 8192;
    const int tid = F.tid;
    for (int it = blockIdx.x; it < BATCH * 4 * 2; it += F.G) {
        const int dir = it & 1, h = (it >> 1) & 3, b = it >> 3;
        const float* wg = dir ? F.wgu_b : F.wgu_f; const float* bg = dir ? F.bg_b : F.bg_f;
        __syncthreads();
        for (int i = tid; i < 1024; i += 512) wup[i] = wg[(i >> 6) * 256 + h * 64 + (i & 63)];
        if (tid < 64) bia[tid] = bg[h * 64 + tid];
        float S[16];
#pragma unroll
        for (int j = 0; j < 16; ++j) S[j] = 0.f;
        bf16* O = dir ? F.OB : F.OF;
        for (int blk = 0; blk < 64; ++blk) {
            __syncthreads();
            { const int i = tid >> 3, sg = tid & 7; const int tok = dir ? (SEQ - 1 - (blk * 64 + i)) : (blk * 64 + i);
              const bf16* rowp = F.PR + (size_t)(b * SEQ + tok) * NPAD;
              const v4u rq = *(const GAS v4u*)(rowp + C_Q + h * 64 + sg * 8), rk = *(const GAS v4u*)(rowp + C_K + h * 64 + sg * 8);
              const v4u rv0 = *(const GAS v4u*)(rowp + C_V + h * 128 + sg * 16), rv1 = *(const GAS v4u*)(rowp + C_V + h * 128 + sg * 16 + 8);
              const v4u g0 = *(const GAS v4u*)(rowp + C_GF + dir * 16), g1 = *(const GAS v4u*)(rowp + C_GF + dir * 16 + 8);
              float* o = qs + i * 64 + sg * 8;
              o[0] = __uint_as_float(rq.x << 16); o[1] = __uint_as_float(rq.x & 0xffff0000u); o[2] = __uint_as_float(rq.y << 16); o[3] = __uint_as_float(rq.y & 0xffff0000u);
              o[4] = __uint_as_float(rq.z << 16); o[5] = __uint_as_float(rq.z & 0xffff0000u); o[6] = __uint_as_float(rq.w << 16); o[7] = __uint_as_float(rq.w & 0xffff0000u);
              o = ks + i * 64 + sg * 8;
              o[0] = __uint_as_float(rk.x << 16); o[1] = __uint_as_float(rk.x & 0xffff0000u); o[2] = __uint_as_float(rk.y << 16); o[3] = __uint_as_float(rk.y & 0xffff0000u);
              o[4] = __uint_as_float(rk.z << 16); o[5] = __uint_as_float(rk.z & 0xffff0000u); o[6] = __uint_as_float(rk.w << 16); o[7] = __uint_as_float(rk.w & 0xffff0000u);
              o = vs + i * 128 + sg * 16;
              o[0] = __uint_as_float(rv0.x << 16); o[1] = __uint_as_float(rv0.x & 0xffff0000u); o[2] = __uint_as_float(rv0.y << 16); o[3] = __uint_as_float(rv0.y & 0xffff0000u);
              o[4] = __uint_as_float(rv0.z << 16); o[5] = __uint_as_float(rv0.z & 0xffff0000u); o[6] = __uint_as_float(rv0.w << 16); o[7] = __uint_as_float(rv0.w & 0xffff0000u);
              o[8] = __uint_as_float(rv1.x << 16); o[9] = __uint_as_float(rv1.x & 0xffff0000u); o[10] = __uint_as_float(rv1.y << 16); o[11] = __uint_as_float(rv1.y & 0xffff0000u);
              o[12] = __uint_as_float(rv1.z << 16); o[13] = __uint_as_float(rv1.z & 0xffff0000u); o[14] = __uint_as_float(rv1.w << 16); o[15] = __uint_as_float(rv1.w & 0xffff0000u);
              float gg[16];
              gg[0] = __uint_as_float(g0.x << 16); gg[1] = __uint_as_float(g0.x & 0xffff0000u); gg[2] = __uint_as_float(g0.y << 16); gg[3] = __uint_as_float(g0.y & 0xffff0000u);
              gg[4] = __uint_as_float(g0.z << 16); gg[5] = __uint_as_float(g0.z & 0xffff0000u); gg[6] = __uint_as_float(g0.w << 16); gg[7] = __uint_as_float(g0.w & 0xffff0000u);
              gg[8] = __uint_as_float(g1.x << 16); gg[9] = __uint_as_float(g1.x & 0xffff0000u); gg[10] = __uint_as_float(g1.y << 16); gg[11] = __uint_as_float(g1.y & 0xffff0000u);
              gg[12] = __uint_as_float(g1.z << 16); gg[13] = __uint_as_float(g1.z & 0xffff0000u); gg[14] = __uint_as_float(g1.w << 16); gg[15] = __uint_as_float(g1.w & 0xffff0000u);
#pragma unroll
              for (int j = 0; j < 8; ++j) { const int d = sg * 8 + j; float pre = bia[d];
#pragma unroll
                  for (int r = 0; r < 16; ++r) pre += gg[r] * wup[r * 64 + d];
                  const float ls = fminf(pre, 0.f) - log1pf(__expf(-fabsf(pre)));
                  as[i * 64 + d] = __expf(ls * (1.f / 16.f)); }
            }
            __syncthreads();
            const int col = tid & 127, dg = tid >> 7;
            for (int i = 0; i < 64; ++i) {
                float p = 0.f; const float vv = vs[i * 128 + col];
#pragma unroll
                for (int j = 0; j < 16; ++j) { const int d = dg * 16 + j; S[j] = as[i * 64 + d] * S[j] + ks[i * 64 + d] * vv; p += qs[i * 64 + d] * S[j]; }
                part[(i & 1) * 512 + dg * 128 + col] = p;
                __syncthreads();
                if (tid < 128) { const float* pp = part + (i & 1) * 512 + tid; const float o = (pp[0] + pp[128]) + (pp[256] + pp[384]);
                    const int tok = dir ? (SEQ - 1 - (blk * 64 + i)) : (blk * 64 + i);
                    O[(size_t)(b * SEQ + tok) * 512 + h * 128 + tid] = (bf16)f2bf(o); }
            }
        }
    }
}

__device__ __forceinline__ void ph_mixbuild(Frame& F) {
    const int gw = blockIdx.x * NWAVES + F.wave, NGW = F.G * NWAVES, lane = F.lane;
    for (int it = gw; it < M * 4; it += NGW) {
        const int h = it & 3; const size_t row = (size_t)(it >> 2);
        const unsigned a = *(const GAS unsigned*)(F.OF + row * 512 + h * 128 + 2 * lane), b = *(const GAS unsigned*)(F.OB + row * 512 + h * 128 + 2 * lane);
        const unsigned zz = *(const GAS unsigned*)(F.PR + row * NPAD + C_ZG + h * 128 + 2 * lane);
        const float o0 = __uint_as_float(a << 16) + __uint_as_float(b << 16), o1 = __uint_as_float(a & 0xffff0000u) + __uint_as_float(b & 0xffff0000u);
        const float ss = wave_sum(o0 * o0 + o1 * o1);
        const float rstd = 1.0f / sqrtf(ss * (1.f / 128.f) + RMS_EPS);
        const float g0 = F.gng[h * 128 + 2 * lane], g1 = F.gng[h * 128 + 2 * lane + 1];
        const float m0 = o0 * rstd * g0 * silu_f(__uint_as_float(zz << 16)), m1 = o1 * rstd * g1 * silu_f(__uint_as_float(zz & 0xffff0000u));
        *(GAS unsigned*)(F.MIX + row * DM + h * 128 + 2 * lane) = pk2(m0, m1);
    }
}

__device__ __forceinline__ void ph_ln(Frame& F, bool bad) {
    const int gw = blockIdx.x * NWAVES + F.wave, NGW = F.G * NWAVES;
    const float qnan = __builtin_nanf("");
    for (int m = gw; m < M; m += NGW) {
        GAS f32x4* xr = (GAS f32x4*)(F.out + (size_t)m * DM) + F.lane;
        f32x4 v[4]; float s = 0.f;
#pragma unroll
        for (int j = 0; j < 4; ++j) { v[j] = xr[64 * j]; s += (v[j].x + v[j].y) + (v[j].z + v[j].w); }
        const float mean = wave_sum(s) * (1.f / DM); float s2 = 0.f;
#pragma unroll
        for (int j = 0; j < 4; ++j) { v[j] = v[j] - mean; s2 += (v[j].x * v[j].x + v[j].y * v[j].y) + (v[j].z * v[j].z + v[j].w * v[j].w); }
        const float rstd = 1.f / sqrtf(wave_sum(s2) * (1.f / DM) + LN_EPS);
#pragma unroll
        for (int j = 0; j < 4; ++j) { const f32x4 g = ((const GAS f32x4*)F.ln_g)[F.lane + 64 * j], bb = ((const GAS f32x4*)F.ln_b)[F.lane + 64 * j];
            f32x4 o = v[j] * rstd * g + bb; if (bad) o = (f32x4){qnan, qnan, qnan, qnan}; xr[64 * j] = o; }
    }
}

constexpr int N_PHASES = 9;
#ifndef MK_N_LAUNCHES
#define MK_N_LAUNCHES 1
#endif
struct Args { const float* in[11]; float* out; unsigned char* ws; int ph_lo, ph_hi, li, pad; };
__global__ void __launch_bounds__(NWAVES * 64, 2) fwd_kernel(Args args) {
    extern __shared__ __attribute__((aligned(16))) unsigned char lds[];
    Frame F;
    F.lds = (LAS unsigned char*)lds;
    F.MISC = (volatile LAS unsigned*)(F.lds + MISC_OFF);
    F.tid = threadIdx.x; F.lane = F.tid & 63; F.wave = __builtin_amdgcn_readfirstlane(F.tid >> 6); F.G = gridDim.x;
    unsigned char* ws = args.ws;
    F.ctl = (gu32*)(ws + WS_CTL);
    F.x = args.in[0]; F.w_in = args.in[1]; F.wgu_f = args.in[2]; F.bg_f = args.in[3]; F.wgu_b = args.in[4]; F.bg_b = args.in[5];
    F.gng = args.in[6]; F.w_fnet = args.in[7]; F.w_out = args.in[8]; F.ln_g = args.in[9]; F.ln_b = args.in[10]; F.out = args.out;
    F.WIN = (bf16*)(ws + WS_WIN); F.WOUT = (bf16*)(ws + WS_WOUT); F.XB = (bf16*)(ws + WS_XB); F.PR = (bf16*)(ws + WS_PR); F.MIX = (bf16*)(ws + WS_MIX);
    F.AP = (bf16*)(ws + WS_AP); F.BP = (bf16*)(ws + WS_BP); F.YR = (bf16*)(ws + WS_YR); F.YI = (bf16*)(ws + WS_YI); F.OF = (bf16*)(ws + WS_OF); F.OB = (bf16*)(ws + WS_OB);
    F.CW = (float*)(ws + WS_CW); F.SW = F.CW + 4 * 128 * 128;
    for (int u = F.tid; u < (LDS_BYTES - LDSCTL_OFF) / 4; u += NWAVES * 64) ((LAS unsigned*)(F.lds + LDSCTL_OFF))[u] = 0u;
    __syncthreads();
    const int lo = args.ph_lo, hi = args.ph_hi;
    const bool use_bar = (hi - lo) > 1;
    XcdBarrier bar; bar.bar = (unsigned*)(F.ctl + CW_BAR) + args.li * XCD_BAR_WORDS; bar.x = 0; bar.st = nullptr;
    if (use_bar) bar = xcd_barrier_post((unsigned*)(F.ctl + CW_BAR) + args.li * XCD_BAR_WORDS, F.MISC + 8);
#define IN(k) (lo <= (k) && (k) < hi)
#define SEAM(k) do { if (IN(k) && IN((k) + 1)) xcd_barrier(bar); } while (0)
    if (IN(0)) { ph_prep(F); SEAM(0); }
    if (IN(1)) {
        pg8::Gemm g{F.XB, F.WIN, M, NPAD, DM}; pg8::StaticOrder S; S.init(M, NPAD, F.G, (int)blockIdx.x);
        pg8::EpiBf16<0> E{F.PR, NPAD, nullptr, 0, 0, 1.f};
        pg8::gemm_phase<pg8::EpiBf16<0>, pg8::StaticOrder, true, true>(F.lds, g, S, E);
        SEAM(1);
    }
    if (IN(2)) { ph_t1(F); SEAM(2); }
    if (IN(3)) { ph_s1(F); SEAM(3); }
    if (IN(4)) { ph_gla_naive(F); SEAM(4); }
    if (IN(5)) { ph_s2(F); SEAM(5); }
    if (IN(6)) { ph_mixbuild(F); SEAM(6); }
    if (IN(7)) {
        pg8::Gemm g{F.MIX, F.WOUT, M, DM, DM}; pg8::StaticOrder S; S.init(M, DM, F.G, (int)blockIdx.x);
        pg8::EpiResF32 E{F.x, F.out, DM, DN_ALPHA};
        pg8::gemm_phase<pg8::EpiResF32, pg8::StaticOrder, true, true>(F.lds, g, S, E);
        SEAM(7);
    }
    if (IN(8)) {
        bool bad = (__hip_atomic_load(F.ctl + CW_TMO, RLX_AGENT) != 0u);
        for (int li = 0; li < 3; ++li) bad |= __hip_atomic_load((gu32*)((const unsigned*)(F.ctl + CW_BAR) + XB_TMO) + li * XCD_BAR_WORDS, RLX_AGENT) != 0u;
        ph_ln(F, bad);
    }
#undef IN
#undef SEAM
}

extern "C" void kernel_launch(void* const* d_in, const int* in_sizes, int n_in, void* d_out, int out_size, void* d_ws, size_t ws_size, hipStream_t stream) {
    static int grid = 0;
    if (grid == 0) {
        if (n_in != 11 || in_sizes[0] != M * DM || out_size != M * DM || ws_size < WS_END) { fprintf(stderr, "kernel_launch: unexpected shapes: n_in %d in0 %d out %d ws %zu (need %zu)\n", n_in, n_in > 0 ? in_sizes[0] : -1, out_size, ws_size, (size_t)WS_END); grid = -1; return; }
        int dev = 0, cus = 0, per_cu = 0;
        if (hipGetDevice(&dev) != hipSuccess || hipDeviceGetAttribute(&cus, hipDeviceAttributeMultiprocessorCount, dev) != hipSuccess) { grid = -1; return; }
        if (hipFuncSetAttribute((const void*)fwd_kernel, hipFuncAttributeMaxDynamicSharedMemorySize, LDS_BYTES) != hipSuccess) { fprintf(stderr, "kernel_launch: hipFuncSetAttribute failed\n"); grid = -1; return; }
        if (hipOccupancyMaxActiveBlocksPerMultiprocessor(&per_cu, (const void*)fwd_kernel, NWAVES * 64, LDS_BYTES) != hipSuccess || per_cu < 1) { fprintf(stderr, "kernel_launch: occupancy query says %d blocks/CU\n", per_cu); per_cu = 1; }
        (void)hipGetLastError();
        grid = cus;
        if (grid > 256) grid = 256;
    }
    if (grid < 0) return;
    if (hipMemsetAsync((char*)d_ws + WS_CTL, 0, CTL_ZERO_BYTES, stream) != hipSuccess) { fprintf(stderr, "kernel_launch: memset failed\n"); return; }
    Args a{};
    for (int i = 0; i < 11; ++i) a.in[i] = (const float*)d_in[i];
    a.out = (float*)d_out; a.ws = (unsigned char*)d_ws;
    constexpr int NL = MK_N_LAUNCHES;
    for (int li = 0; li < NL; ++li) {
        if (NL == 1) { a.ph_lo = 0; a.ph_hi = N_PHASES; } else { a.ph_lo = li; a.ph_hi = li + 1; }
        a.li = (NL == 1) ? 0 : 0;
        hipLaunchKernelGGL(fwd_kernel, dim3(grid), dim3(NWAVES * 64), LDS_BYTES, stream, a);
        const hipError_t le = hipPeekAtLastError();
        if (le != hipSuccess) { fprintf(stderr, "kernel_launch: launch %d failed: %s\n", li, hipGetErrorName(le)); break; }
    }
}
```

```cpp
#include <hip/hip_runtime.h>
#include <cstdio>
#include <cstdint>
namespace pg8 {
#define PG8_LAS __attribute__((address_space(3)))
typedef unsigned short bf16_t;
typedef short bf16x8 __attribute__((ext_vector_type(8)));
typedef float f32x4 __attribute__((ext_vector_type(4)));
typedef unsigned u32x4 __attribute__((ext_vector_type(4)));
constexpr int BM = 256, BK = 64, HALF = 128, HTB = HALF * BK * 2  , STAGE_BYTES = 8 * HTB, NXCD = 8, WGM = 8;

__host__ __device__ __forceinline__ int lds_byte(int r, int c) { const int st = (r >> 4) * 2 + (c >> 5), rr = r & 15, cc = c & 31, ob = rr * 64 + cc * 2; return st * 1024 + (ob ^ (((ob >> 9) & 1) << 5)); }
__host__ __device__ __forceinline__ void stage_rc(int b, int& R, int& C) { const int st = b / 1024, sb = b % 1024, swz = sb ^ (((sb >> 9) & 1) << 5); R = (st >> 1) * 16 + swz / 64; C = (st & 1) * 32 + (swz % 64) / 2; }
__host__ __device__ __forceinline__ int perm32(int rho) { const int n = rho >> 4, i = rho & 15; return 8 * (i >> 2) + 4 * n + (i & 3); }

struct Unit { int pm, pn; };
struct Gemm { const bf16_t* A; const bf16_t* Bt; int M, N, K; };

struct StaticOrder {
    int nM, nN, nwg, G, c;
    __host__ __device__ void init(int M, int N, int G_, int c_) { nM = M / BM; nN = N / BM; nwg = nM * nN; G = G_; c = c_; }
    __host__ __device__ bool next(int i, Unit& u) const {
        const long L = (long)i * G + c; if (L >= nwg) return false;
        int wgid = (int)L; { const int q = nwg / NXCD, r = nwg % NXCD, xcd = wgid % NXCD, off = wgid / NXCD; wgid = (xcd < r ? xcd * (q + 1) : r * (q + 1) + (xcd - r) * q) + off; }
        const int nig = WGM * nN, gid = wgid / nig, fm = gid * WGM, gsz = (nM - fm) < WGM ? (nM - fm) : WGM;
        u.pm = fm + ((wgid % nig) % gsz); u.pn = (wgid % nig) / gsz; return true;
    }
    __device__ __forceinline__ void a_ready(const Unit&) const {}
    __device__ __forceinline__ void done(const Unit&) const {}
};

__device__ __forceinline__ unsigned cvt_pk_bf16(float lo, float hi) { unsigned r; asm volatile("v_cvt_pk_bf16_f32 %0, %1, %2" : "=v"(r) : "v"(lo), "v"(hi)); return r; }
typedef float f32x2 __attribute__((ext_vector_type(2)));
__device__ __forceinline__ f32x2 gelu_pk(f32x2 v) {
    const f32x2 av = __builtin_elementwise_abs(v), d = av * 0.2316418882f + 1.0f;
    f32x2 t; t.x = __builtin_amdgcn_rcpf(d.x); t.y = __builtin_amdgcn_rcpf(d.y);
    f32x2 q = t * 0.5307027145f + (-0.7265760135f); q = q * t + 0.7107068705f; q = q * t + (-0.142248368f); q = q * t + 0.127414796f; q = q * t;
    const f32x2 s = (v * v) * (-0.72134752044f);
    f32x2 e; e.x = __builtin_amdgcn_exp2f(s.x); e.y = __builtin_amdgcn_exp2f(s.y);
    const f32x2 m = v * (q * e), r = v - m;
    f32x2 o; o.x = v.x < 0.f ? m.x : r.x; o.y = v.y < 0.f ? m.y : r.y; return o;
}

template <int ACT  > struct EpiBf16 {
    static constexpr bool PERM = true, AFTER_DRAIN = false; static_assert(ACT == 0 || ACT == 1, "EpiBf16: ACT is 0 (none) or 1 (gelu_pk)");
    bf16_t* O; int ldc; const float* bias; int split_cols; size_t split_stride; float scale0;
    __device__ __forceinline__ void operator()(const f32x4 (&acc)[2][2][4][2], const Unit& u, int wr, int wc, int fr, int fq) const {
        const int row0 = u.pm * BM + wr * 64 + fr; int colt = u.pn * BM; bf16_t* base = O;
        float sc = 1.f; if (split_cols) { const int t = colt / split_cols; base += (size_t)t * split_stride; colt -= t * split_cols; if (t == 0) sc = scale0; }
        const int col0 = colt + wc * 32 + 8 * fq, bcol0 = u.pn * BM + wc * 32 + 8 * fq;
        f32x4 bv[2][2];
#pragma unroll
        for (int bj = 0; bj < 2; ++bj)
#pragma unroll
            for (int n = 0; n < 2; ++n) bv[bj][n] = bias ? *(const f32x4*)(bias + bcol0 + bj * HALF + 4 * n) : (f32x4){0.f, 0.f, 0.f, 0.f};
#pragma unroll
        for (int ai = 0; ai < 2; ++ai)
#pragma unroll
            for (int m = 0; m < 4; ++m) { bf16_t* rowp = base + (size_t)(row0 + ai * HALF + m * 16) * ldc + col0;
#pragma unroll
                for (int bj = 0; bj < 2; ++bj) { f32x4 v0 = acc[ai][bj][m][0] + bv[bj][0], v1 = acc[ai][bj][m][1] + bv[bj][1];
                    if (ACT == 1) { f32x2 a = gelu_pk((f32x2){v0[0], v0[1]}), b = gelu_pk((f32x2){v0[2], v0[3]}), c = gelu_pk((f32x2){v1[0], v1[1]}), d = gelu_pk((f32x2){v1[2], v1[3]});
                        v0 = (f32x4){a.x, a.y, b.x, b.y}; v1 = (f32x4){c.x, c.y, d.x, d.y}; }
                    v0 = v0 * sc; v1 = v1 * sc; u32x4 w; w.x = cvt_pk_bf16(v0[0], v0[1]); w.y = cvt_pk_bf16(v0[2], v0[3]); w.z = cvt_pk_bf16(v1[0], v1[1]); w.w = cvt_pk_bf16(v1[2], v1[3]);
                    *(u32x4*)(rowp + bj * HALF) = w; } }
    }
};

struct PanelStats {
    unsigned* xbuf;
    unsigned* cnt;
    unsigned* tmo;
    int ntn; float eps;
    unsigned code;
    __device__ __forceinline__ bool run(const f32x4 (&v)[2][2][4][2], const Unit& u, int wr, int wc, int fr, int fq, PG8_LAS unsigned char* lds, int wid, int lane) const {
        typedef float f32x2v __attribute__((ext_vector_type(2)));
        PG8_LAS f32x2v* P = (PG8_LAS f32x2v*)lds;
        PG8_LAS f32x2v* S = (PG8_LAS f32x2v*)(lds + 8192);
        PG8_LAS unsigned* flag = (PG8_LAS unsigned*)(lds + 8192 + 2048);
#pragma unroll
        for (int ai = 0; ai < 2; ++ai)
#pragma unroll
            for (int m = 0; m < 4; ++m) {
                float s = 0.f;
#pragma unroll
                for (int bj = 0; bj < 2; ++bj)
#pragma unroll
                    for (int n = 0; n < 2; ++n) { const f32x4 x = v[ai][bj][m][n]; s += (x[0] + x[1]) + (x[2] + x[3]); }
                s += __shfl_xor(s, 16); s += __shfl_xor(s, 32);
                const float mw = s * (1.0f / 64.0f); float q = 0.f;
#pragma unroll
                for (int bj = 0; bj < 2; ++bj)
#pragma unroll
                    for (int n = 0; n < 2; ++n) { const f32x4 d = v[ai][bj][m][n] - mw; q += (d[0] * d[0] + d[1] * d[1]) + (d[2] * d[2] + d[3] * d[3]); }
                q += __shfl_xor(q, 16); q += __shfl_xor(q, 32);
                if (fq == 0) P[(ai * HALF + wr * 64 + m * 16 + fr) * 4 + wc] = (f32x2v){mw, q};
            }
        asm volatile("s_waitcnt lgkmcnt(0)" ::: "memory"); __builtin_amdgcn_s_barrier(); asm volatile("" ::: "memory");
#if defined(BROKEN_EXCHANGE_NO_WAIT)
#warning BROKEN CONTROL BUILD: the row-statistics exchange does not wait; results are wrong by design
        if (blockIdx.x >= 64) { const long long t0_ = clock64(); while (clock64() - t0_ < 60000) __builtin_amdgcn_s_sleep(8); }
#endif
        const int row = wid * 32 + (lane & 31);
        if (lane < 32) {
            const f32x2v a = P[row * 4 + 0], b = P[row * 4 + 1], c = P[row * 4 + 2], d = P[row * 4 + 3];
            const float mt = (a.x + b.x + c.x + d.x) * 0.25f;
            const float da = a.x - mt, db = b.x - mt, dc = c.x - mt, dd = d.x - mt;
            const float m2 = (a.y + b.y) + (c.y + d.y) + 64.0f * ((da * da + db * db) + (dc * dc + dd * dd));
            unsigned long long* slot = (unsigned long long*)xbuf + ((size_t)(u.pm * BM + row) * 4 + u.pn);
            __hip_atomic_store(slot, ((unsigned long long)__float_as_uint(m2) << 32) | __float_as_uint(mt), __ATOMIC_RELAXED, __HIP_MEMORY_SCOPE_AGENT);
        }
        asm volatile("s_waitcnt vmcnt(0)" ::: "memory");
        if (lane == 0) __hip_atomic_fetch_add(cnt + 64 * u.pm, 1u, __ATOMIC_RELAXED, __HIP_MEMORY_SCOPE_AGENT);
        if (wid == 0) {
            bool dead = false; const unsigned long long t0 = __builtin_amdgcn_s_memrealtime(); const unsigned want = 8u * (unsigned)ntn;
            for (;;) {
#if defined(BROKEN_EXCHANGE_NO_WAIT)
                break;
#endif
                if ((unsigned)__builtin_amdgcn_readfirstlane(__hip_atomic_load(cnt + 64 * u.pm, __ATOMIC_RELAXED, __HIP_MEMORY_SCOPE_AGENT)) >= want) break;
                if (__builtin_amdgcn_s_memrealtime() - t0 > 2000000ull) {
                    if (lane == 0) { unsigned expect = 0u; __hip_atomic_compare_exchange_strong(tmo + 1, &expect, code | (unsigned)(u.pm & 0xff), __ATOMIC_RELAXED, __ATOMIC_RELAXED, __HIP_MEMORY_SCOPE_AGENT);
                                     __hip_atomic_store(tmo, 1u, __ATOMIC_RELAXED, __HIP_MEMORY_SCOPE_AGENT); }
                    dead = true; break; }
                __builtin_amdgcn_s_sleep(2);
            }
            __builtin_amdgcn_fence(__ATOMIC_ACQUIRE, "agent");
            if (lane == 0) flag[0] = dead ? 1u : 0u;
        }
        asm volatile("s_waitcnt vmcnt(0) lgkmcnt(0)" ::: "memory"); __builtin_amdgcn_s_barrier(); asm volatile("" ::: "memory");
        const bool bad = flag[0] != 0u;
        if (lane < 32) {
            const unsigned long long* slot = (const unsigned long long*)xbuf + (size_t)(u.pm * BM + row) * 4; float mt[4], m2[4]; float ms = 0.f;
#pragma unroll
            for (int t = 0; t < 4; ++t) { if (t < ntn) { const unsigned long long w = __hip_atomic_load(slot + t, __ATOMIC_RELAXED, __HIP_MEMORY_SCOPE_AGENT); mt[t] = __uint_as_float((unsigned)w); m2[t] = __uint_as_float((unsigned)(w >> 32)); } else { mt[t] = 0.f; m2[t] = 0.f; } ms += mt[t]; }
            const float mean = ms / (float)ntn; float q = 0.f;
#pragma unroll
            for (int t = 0; t < 4; ++t) if (t < ntn) { const float dm = mt[t] - mean; q += m2[t] + 256.0f * dm * dm; }
            S[row] = (f32x2v){mean, 1.0f / sqrtf(q / (256.0f * (float)ntn) + eps)};
        }
        asm volatile("s_waitcnt lgkmcnt(0)" ::: "memory"); __builtin_amdgcn_s_barrier(); asm volatile("" ::: "memory");
        return bad;
    }
};
struct EpiLnRes {
    static constexpr bool PERM = false, AFTER_DRAIN = true;
    const float* base; float* out; int ldc; const float* bias; PanelStats st; unsigned poison;
    __device__ __forceinline__ void fused(f32x4 (&acc)[2][2][4][2], const Unit& u, int wr, int wc, int fr, int fq, PG8_LAS unsigned char* lds, int wid, int lane) const {
        typedef float f32x2v __attribute__((ext_vector_type(2)));
        const PG8_LAS f32x2v* S = (const PG8_LAS f32x2v*)(lds + 8192);
        const int col0 = u.pn * BM + wc * 32 + 4 * fq;
#pragma unroll
        for (int bj = 0; bj < 2; ++bj)
#pragma unroll
            for (int n = 0; n < 2; ++n) { const f32x4 bv = bias ? *(const f32x4*)(bias + col0 + bj * HALF + n * 16) : (f32x4){0.f, 0.f, 0.f, 0.f};
#pragma unroll
                for (int ai = 0; ai < 2; ++ai)
#pragma unroll
                    for (int m = 0; m < 4; ++m) acc[ai][bj][m][n] += bv; }
        f32x4 pre[4][2][2];
#pragma unroll
        for (int m = 0; m < 4; ++m) { const size_t off = (size_t)(u.pm * BM + wr * 64 + m * 16 + fr) * ldc + col0;
#pragma unroll
            for (int bj = 0; bj < 2; ++bj)
#pragma unroll
                for (int n = 0; n < 2; ++n) pre[m][bj][n] = *(const f32x4*)(base + off + bj * HALF + n * 16); }
        const bool bad = st.run(acc, u, wr, wc, fr, fq, lds, wid, lane) || poison != 0u;
        const float qnan = __builtin_nanf("");
#pragma unroll
        for (int ai = 0; ai < 2; ++ai)
#pragma unroll
            for (int m = 0; m < 4; ++m) { const int r = ai * HALF + wr * 64 + m * 16 + fr; const f32x2v sr = S[r]; const size_t off = (size_t)(u.pm * BM + r) * ldc + col0;
#pragma unroll
                for (int bj = 0; bj < 2; ++bj)
#pragma unroll
                    for (int n = 0; n < 2; ++n) { const f32x4 bs = ai == 0 ? pre[m][bj][n] : *(const f32x4*)(base + off + bj * HALF + n * 16); f32x4 o = bs + (acc[ai][bj][m][n] - sr.x) * sr.y;
                        if (bad) o = (f32x4){qnan, qnan, qnan, qnan}; *(f32x4*)(out + off + bj * HALF + n * 16) = o; }
                if (m & 1) asm volatile("" ::: "memory"); }
    }
};
struct EpiLnResLn {
    static constexpr bool PERM = false, AFTER_DRAIN = true;
    const float* base; float* out; bf16_t* xn; int ldc; const float* bias; PanelStats st1, st2; unsigned poison;
    __device__ __forceinline__ void fused(f32x4 (&acc)[2][2][4][2], const Unit& u, int wr, int wc, int fr, int fq, PG8_LAS unsigned char* lds, int wid, int lane) const {
        typedef float f32x2v __attribute__((ext_vector_type(2))); typedef unsigned u32x2v __attribute__((ext_vector_type(2)));
        const PG8_LAS f32x2v* S = (const PG8_LAS f32x2v*)(lds + 8192);
        const int col0 = u.pn * BM + wc * 32 + 4 * fq;
#pragma unroll
        for (int bj = 0; bj < 2; ++bj)
#pragma unroll
            for (int n = 0; n < 2; ++n) { const f32x4 bv = bias ? *(const f32x4*)(bias + col0 + bj * HALF + n * 16) : (f32x4){0.f, 0.f, 0.f, 0.f};
#pragma unroll
                for (int ai = 0; ai < 2; ++ai)
#pragma unroll
                    for (int m = 0; m < 4; ++m) acc[ai][bj][m][n] += bv; }
        bool bad = st1.run(acc, u, wr, wc, fr, fq, lds, wid, lane) || poison != 0u;
        const float qnan = __builtin_nanf("");
#pragma unroll
        for (int ai = 0; ai < 2; ++ai)
#pragma unroll
            for (int m = 0; m < 4; ++m) { const int r = ai * HALF + wr * 64 + m * 16 + fr; const f32x2v sr = S[r]; const size_t off = (size_t)(u.pm * BM + r) * ldc + col0;
#pragma unroll
                for (int bj = 0; bj < 2; ++bj)
#pragma unroll
                    for (int n = 0; n < 2; ++n) { const f32x4 bs = *(const f32x4*)(base + off + bj * HALF + n * 16); acc[ai][bj][m][n] = bs + (acc[ai][bj][m][n] - sr.x) * sr.y; }
                asm volatile("" : "+v"(acc[ai][0][m][0]), "+v"(acc[ai][0][m][1]), "+v"(acc[ai][1][m][0]), "+v"(acc[ai][1][m][1]));
                if (m & 1) asm volatile("" ::: "memory"); }
        const bool bad1 = bad;
        bad = st2.run(acc, u, wr, wc, fr, fq, lds, wid, lane) || bad;
#pragma unroll
        for (int ai = 0; ai < 2; ++ai)
#pragma unroll
            for (int m = 0; m < 4; ++m) { const int r = ai * HALF + wr * 64 + m * 16 + fr; const f32x2v sr = S[r]; const size_t off = (size_t)(u.pm * BM + r) * ldc + col0;
#pragma unroll
                for (int bj = 0; bj < 2; ++bj)
#pragma unroll
                    for (int n = 0; n < 2; ++n) { const f32x4 x1 = acc[ai][bj][m][n]; *(f32x4*)(out + off + bj * HALF + n * 16) = bad1 ? (f32x4){qnan, qnan, qnan, qnan} : x1;
                        const f32x4 o = (x1 - sr.x) * sr.y; u32x2v w; w.x = cvt_pk_bf16(o[0], o[1]); w.y = cvt_pk_bf16(o[2], o[3]);
                        if (bad) { w.x = 0x7fc07fc0u; w.y = 0x7fc07fc0u; } *(u32x2v*)(xn + off + bj * HALF + n * 16) = w; }
                asm volatile("" ::: "memory"); }
    }
};


struct EpiResF32 {
    static constexpr bool PERM = false, AFTER_DRAIN = false;
    const float* base; float* out; int ldc; float alpha;
    __device__ __forceinline__ void operator()(const f32x4 (&acc)[2][2][4][2], const Unit& u, int wr, int wc, int fr, int fq) const {
        const int col0 = u.pn * BM + wc * 32 + 4 * fq;
#pragma unroll
        for (int ai = 0; ai < 2; ++ai)
#pragma unroll
            for (int m = 0; m < 4; ++m) { const size_t off = (size_t)(u.pm * BM + ai * HALF + wr * 64 + m * 16 + fr) * ldc + col0;
#pragma unroll
                for (int bj = 0; bj < 2; ++bj)
#pragma unroll
                    for (int n = 0; n < 2; ++n) { const f32x4 bs = *(const f32x4*)(base + off + bj * HALF + n * 16); *(f32x4*)(out + off + bj * HALF + n * 16) = bs * alpha + acc[ai][bj][m][n]; }
                if (m & 1) asm volatile("" ::: "memory"); }
    }
};
template <class Epi, class Sched, bool ALIGN_EPI = false, bool SP2 = false>
__device__ __forceinline__ void gemm_phase(PG8_LAS unsigned char* lds, const Gemm g, const Sched& S, const Epi& E) {
    const int tid = threadIdx.x, wid = __builtin_amdgcn_readfirstlane(tid >> 6), lane = tid & 63, wr = wid >> 2, wc = wid & 3, fr = lane & 15, fq = lane >> 4;
    const int K = g.K, nt = K / BK;
    unsigned voffA[2], voffB[2];
#pragma unroll
    for (int i = 0; i < 2; ++i) { int R, C; stage_rc(tid * 16 + i * 8192, R, C); const int Rb = Epi::PERM ? ((R & ~31) + perm32(R & 31)) : R;
        voffA[i] = (unsigned)(R * K + C) * 2u; voffB[i] = (unsigned)(Rb * K + C) * 2u; }
    const size_t kstep = (size_t)(BK * 2);
    const size_t hstep = (size_t)HALF * K * 2;
    const size_t tstep = 2 * hstep;
    const unsigned ldsw = (unsigned)wid * 1024u;
    const int aoff = lds_byte(wr * 64 + fr, fq * 8), boff = lds_byte(wc * 32 + fr, fq * 8);
#define PG8_SA(b, h) (((b) * 2 + (h)) * HTB)
#define PG8_SB(b, h) ((4 + (b) * 2 + (h)) * HTB)
#define PG8_STAGE(bufoff, gbase, voff) do { _Pragma("unroll") for (int _i = 0; _i < 2; ++_i) \
        __builtin_amdgcn_global_load_lds((const unsigned*)((const char*)(gbase) + (voff)[_i]), (PG8_LAS unsigned*)(lds + (bufoff) + ldsw + _i * 8192), 16, 0, 0); } while (0)
#define PG8_LDA(dst, b, h) do { _Pragma("unroll") for (int m = 0; m < 4; ++m) _Pragma("unroll") for (int k = 0; k < 2; ++k) dst[m][k] = *(const PG8_LAS bf16x8*)(lds + PG8_SA(b, h) + aoff + m * 2048 + k * 1024); } while (0)
#define PG8_LDB(dst, b, h) do { _Pragma("unroll") for (int n = 0; n < 2; ++n) _Pragma("unroll") for (int k = 0; k < 2; ++k) dst[n][k] = *(const PG8_LAS bf16x8*)(lds + PG8_SB(b, h) + boff + n * 2048 + k * 1024); } while (0)
#define PG8_MMA(ai, bj, At, Bt) do { __builtin_amdgcn_s_setprio(1); _Pragma("unroll") for (int m = 0; m < 4; ++m) _Pragma("unroll") for (int n = 0; n < 2; ++n) _Pragma("unroll") for (int k = 0; k < 2; ++k) \
        acc[ai][bj][m][n] = __builtin_amdgcn_mfma_f32_16x16x32_bf16(Bt[n][k], At[m][k], acc[ai][bj][m][n], 0, 0, 0); __builtin_amdgcn_s_setprio(0); } while (0)
#define PG8_WAIT_V(n) asm volatile("s_waitcnt vmcnt(" #n ")" ::: "memory")
#define PG8_WAIT_L(n) asm volatile("s_waitcnt lgkmcnt(" #n ")" ::: "memory")
#define PG8_BAR __builtin_amdgcn_s_barrier()
#define PG8_SCHED __builtin_amdgcn_sched_barrier(0)
    Unit cur, nxt; int ui = 0;
    if (!S.next(0, cur)) return;
    f32x4 acc[2][2][4][2];
#pragma unroll
    for (int a = 0; a < 2; ++a)
#pragma unroll
        for (int b = 0; b < 2; ++b)
#pragma unroll
            for (int m = 0; m < 4; ++m)
#pragma unroll
                for (int n = 0; n < 2; ++n) acc[a][b][m][n] = (f32x4){0.f, 0.f, 0.f, 0.f};
    bf16x8 At[4][2], B0[2][2], B1[2][2];
    const char* cA = (const char*)g.A + (size_t)cur.pm * tstep; const char* cB = (const char*)g.Bt + (size_t)cur.pn * tstep;
    S.a_ready(cur);
    if constexpr (SP2) {
        PG8_STAGE(PG8_SB(0, 0), cB, voffB); PG8_STAGE(PG8_SB(0, 1), cB + hstep, voffB); PG8_STAGE(PG8_SA(0, 0), cA, voffA); PG8_STAGE(PG8_SA(0, 1), cA + hstep, voffA);
        if (wr == 1) PG8_BAR;
        PG8_WAIT_V(2); PG8_BAR;
        PG8_STAGE(PG8_SB(1, 0), cB + kstep, voffB); PG8_STAGE(PG8_SA(1, 0), cA + kstep, voffA); PG8_STAGE(PG8_SB(1, 1), cB + hstep + kstep, voffB);
        PG8_WAIT_V(6); PG8_BAR;
    } else {
        PG8_STAGE(PG8_SB(0, 0), cB, voffB); PG8_STAGE(PG8_SA(0, 0), cA, voffA); PG8_STAGE(PG8_SB(0, 1), cB + hstep, voffB); PG8_STAGE(PG8_SA(0, 1), cA + hstep, voffA);
        if (wr == 1) PG8_BAR;
        PG8_WAIT_V(4); PG8_BAR;
        PG8_STAGE(PG8_SB(1, 0), cB + kstep, voffB); PG8_STAGE(PG8_SA(1, 0), cA + kstep, voffA); PG8_STAGE(PG8_SB(1, 1), cB + hstep + kstep, voffB);
        PG8_WAIT_V(6); PG8_BAR;
    }
    for (;;) {
        const bool has_next = S.next(ui + 1, nxt);
        const char* nA = has_next ? (const char*)g.A + (size_t)nxt.pm * tstep : cA; const char* nB = has_next ? (const char*)g.Bt + (size_t)nxt.pn * tstep : cB;
        for (int t = 0; t < nt; t += 2) {
            const bool last = (t == nt - 2);
            const char* a1 = cA + (size_t)(t + 1) * kstep;
            const char* a2 = last ? nA : cA + (size_t)(t + 2) * kstep; const char* b2 = last ? nB : cB + (size_t)(t + 2) * kstep;
            const char* a3 = a2 + kstep; const char* b3 = b2 + kstep;
            if (last && has_next) S.a_ready(nxt);
            if constexpr (SP2) {
            PG8_LDB(B0, 0, 0); PG8_LDB(B1, 0, 1); PG8_SCHED; PG8_LDA(At, 0, 0); PG8_STAGE(PG8_SA(1, 1), a1 + hstep, voffA);
            PG8_WAIT_V(8); PG8_WAIT_L(0); PG8_BAR; PG8_MMA(0, 0, At, B0); PG8_MMA(0, 1, At, B1); PG8_BAR; PG8_SCHED;
            PG8_LDA(At, 0, 1); PG8_STAGE(PG8_SB(0, 0), b2, voffB); PG8_STAGE(PG8_SB(0, 1), b2 + hstep, voffB); PG8_STAGE(PG8_SA(0, 0), a2, voffA);
            PG8_WAIT_V(8); PG8_WAIT_L(0); PG8_BAR; PG8_MMA(1, 0, At, B0); PG8_MMA(1, 1, At, B1); PG8_BAR; PG8_SCHED;
            PG8_LDB(B0, 1, 0); PG8_LDB(B1, 1, 1); PG8_SCHED; PG8_LDA(At, 1, 0); PG8_STAGE(PG8_SA(0, 1), a2 + hstep, voffA);
            PG8_WAIT_V(8); PG8_WAIT_L(0); PG8_BAR; PG8_MMA(0, 0, At, B0); PG8_MMA(0, 1, At, B1); PG8_BAR; PG8_SCHED;
            PG8_LDA(At, 1, 1); PG8_STAGE(PG8_SB(1, 0), b3, voffB); PG8_STAGE(PG8_SB(1, 1), b3 + hstep, voffB); PG8_STAGE(PG8_SA(1, 0), a3, voffA);
            PG8_WAIT_V(8); PG8_WAIT_L(0); PG8_BAR; PG8_MMA(1, 0, At, B0); PG8_MMA(1, 1, At, B1); PG8_BAR; PG8_SCHED;
            } else {
            PG8_LDB(B0, 0, 0); PG8_SCHED; PG8_LDA(At, 0, 0); PG8_STAGE(PG8_SA(1, 1), a1 + hstep, voffA);
            PG8_WAIT_L(8); PG8_BAR; PG8_WAIT_L(0); PG8_MMA(0, 0, At, B0); PG8_BAR; PG8_SCHED;
            PG8_LDB(B1, 0, 1); PG8_STAGE(PG8_SB(0, 0), b2, voffB);
            PG8_BAR; PG8_WAIT_L(0); PG8_MMA(0, 1, At, B1); PG8_BAR;
            PG8_LDA(At, 0, 1); PG8_STAGE(PG8_SA(0, 0), a2, voffA);
            PG8_BAR; PG8_WAIT_L(0); PG8_MMA(1, 0, At, B0); PG8_BAR; PG8_SCHED;
            PG8_STAGE(PG8_SB(0, 1), b2 + hstep, voffB);
            PG8_WAIT_V(6); PG8_BAR; PG8_MMA(1, 1, At, B1); PG8_BAR;
            PG8_LDB(B0, 1, 0); PG8_SCHED; PG8_LDA(At, 1, 0); PG8_STAGE(PG8_SA(0, 1), a2 + hstep, voffA);
            PG8_WAIT_L(8); PG8_BAR; PG8_WAIT_L(0); PG8_MMA(0, 0, At, B0); PG8_BAR; PG8_SCHED;
            PG8_LDB(B1, 1, 1); PG8_STAGE(PG8_SB(1, 0), b3, voffB);
            PG8_BAR; PG8_WAIT_L(0); PG8_MMA(0, 1, At, B1); PG8_BAR;
            PG8_LDA(At, 1, 1); PG8_STAGE(PG8_SA(1, 0), a3, voffA);
            PG8_BAR; PG8_WAIT_L(0); PG8_MMA(1, 0, At, B0); PG8_BAR; PG8_SCHED;
            PG8_STAGE(PG8_SB(1, 1), b3 + hstep, voffB);
            PG8_WAIT_V(6); PG8_BAR; PG8_MMA(1, 1, At, B1); PG8_BAR;
            }
        }
        if constexpr (ALIGN_EPI) { if (wr == 0) PG8_BAR; }
        if constexpr (!Epi::AFTER_DRAIN) { E(acc, cur, wr, wc, fr, fq); S.done(cur); }
        if (!has_next) break;
#pragma unroll
        for (int a = 0; a < 2; ++a)
#pragma unroll
            for (int b = 0; b < 2; ++b)
#pragma unroll
                for (int m = 0; m < 4; ++m)
#pragma unroll
                    for (int n = 0; n < 2; ++n) acc[a][b][m][n] = (f32x4){0.f, 0.f, 0.f, 0.f};
        cur = nxt; cA = nA; cB = nB; ++ui;
        if constexpr (ALIGN_EPI) { if (wr == 1) PG8_BAR; }
    }
    PG8_WAIT_V(0);
    if constexpr (!ALIGN_EPI) { if (wr == 0) PG8_BAR; }
    PG8_BAR;
    if constexpr (Epi::AFTER_DRAIN) { E.fused(acc, cur, wr, wc, fr, fq, lds, wid, lane); S.done(cur); }
#undef PG8_SA
#undef PG8_SB
#undef PG8_STAGE
#undef PG8_LDA
#undef PG8_LDB
#undef PG8_MMA
#undef PG8_WAIT_V
#undef PG8_WAIT_L
#undef PG8_BAR
#undef PG8_SCHED
}
}

#define GAS __attribute__((address_space(1)))
#define LAS __attribute__((address_space(3)))
typedef unsigned short bf16;
typedef unsigned v4u __attribute__((ext_vector_type(4)));
typedef float f32x4 __attribute__((ext_vector_type(4)));
typedef short bf16x8 __attribute__((ext_vector_type(8)));
typedef GAS unsigned gu32;
typedef GAS unsigned long long gu64;
#define RLX_AGENT __ATOMIC_RELAXED, __HIP_MEMORY_SCOPE_AGENT
#define LDS_WAIT() asm volatile("s_waitcnt lgkmcnt(0)" ::: "memory")
#define VM_WAIT() asm volatile("s_waitcnt vmcnt(0)" ::: "memory")
__device__ __forceinline__ unsigned long long rt() { return __builtin_amdgcn_s_memrealtime(); }
__device__ __forceinline__ unsigned f2bf(float f) { unsigned u = __builtin_bit_cast(unsigned, f); return (u + 0x7fffu + ((u >> 16) & 1u)) >> 16; }
__device__ __forceinline__ unsigned pk2(float lo, float hi) { return f2bf(lo) | (f2bf(hi) << 16); }

#define XB_TMO      128
#define XB_XCNT(j)  (256  + 64 * (j))
#define XB_XSUB(j)  (1280 + 64 * (j))
#define XB_XGEN(j)  (2304 + 64 * (j))
#define XB_TOP      3328
#define XB_TOPGEN   3392
#define XCD_BAR_WORDS 3456
#define XB_SPIN_CAP (1u << 18)

__device__ __forceinline__ unsigned xb_ld(unsigned* p)              { return __hip_atomic_load(p, __ATOMIC_RELAXED, __HIP_MEMORY_SCOPE_AGENT); }
__device__ __forceinline__ unsigned xb_add(unsigned* p, unsigned v) { return __hip_atomic_fetch_add(p, v, __ATOMIC_RELAXED, __HIP_MEMORY_SCOPE_AGENT); }
__device__ __forceinline__ unsigned xb_xcc_id() { return (unsigned)__builtin_amdgcn_s_getreg((3 << 11) | 20) & 0xFu; }
#define XB_SPIN(cond, bar) do { unsigned _sp = 0; while (cond) { __builtin_amdgcn_s_sleep(1); \
    if ((++_sp & 255u) == 0u) { if (xb_ld(&(bar)[XB_TMO])) break; if (_sp > XB_SPIN_CAP) { atomicAdd(&(bar)[XB_TMO], 1u); break; } } } } while (0)

struct XcdBarrier {
    unsigned* bar; unsigned x;
    volatile LAS unsigned* st;
};

__device__ __forceinline__ XcdBarrier xcd_barrier_post(unsigned* bar, volatile LAS unsigned* st) {
    XcdBarrier b; b.bar = bar; b.x = xb_xcc_id(); b.st = st;
    if (threadIdx.x == 0) (void)xb_add(&bar[XB_XCNT(b.x)], 1u);
    return b;
}
__device__ __forceinline__ void xcd_barrier_complete(unsigned* bar, unsigned x, unsigned& nloc, unsigned& nx) {
    const unsigned G = gridDim.x * gridDim.y * gridDim.z;
    unsigned sum, cnt, mine, sp = 0u;
    for (;;) {
        sum = 0u; cnt = 0u; mine = 0u;
#pragma unroll
        for (unsigned j = 0; j < 16; ++j) { const unsigned c = xb_ld(&bar[XB_XCNT(j)]); sum += c; cnt += (c > 0u) ? 1u : 0u; mine = (j == x) ? c : mine; }
        if (sum == G) break;
        __builtin_amdgcn_s_sleep(1);
        if ((++sp & 255u) == 0u) { if (xb_ld(&bar[XB_TMO])) break; if (sp > XB_SPIN_CAP) { atomicAdd(&bar[XB_TMO], 1u); break; } }
    }
    nloc = mine > 0u ? mine : 1u; nx = cnt > 0u ? cnt : 1u;
}

__device__ __forceinline__ void xcd_barrier(const XcdBarrier& b) {
    asm volatile("s_waitcnt vmcnt(0)" ::: "memory");
    __syncthreads();
    if (threadIdx.x == 0) {
        unsigned* bar = b.bar;
        __builtin_amdgcn_s_waitcnt(0);
        unsigned nloc = b.st[0], nx = b.st[1];
        if (nloc == 0u) { xcd_barrier_complete(bar, b.x, nloc, nx); b.st[0] = nloc; b.st[1] = nx; }
        const unsigned old = xb_add(&bar[XB_XSUB(b.x)], 1u);
        const unsigned gen = old / nloc;
        if (old + 1u == (gen + 1u) * nloc) {
            __builtin_amdgcn_fence(__ATOMIC_RELEASE, "agent");
            asm volatile("s_waitcnt vmcnt(0)" ::: "memory");
            const unsigned og = xb_add(&bar[XB_TOP], 1u);
            const unsigned tg = og / nx;
            if (og + 1u == (tg + 1u) * nx) xb_add(&bar[XB_TOPGEN], 1u);
            else XB_SPIN(xb_ld(&bar[XB_TOPGEN]) == tg, bar);
            __builtin_amdgcn_fence(__ATOMIC_ACQUIRE, "agent");
            xb_add(&bar[XB_XGEN(b.x)], 1u);
            asm volatile("s_waitcnt vmcnt(0)" ::: "memory");
        } else {
            XB_SPIN(xb_ld(&bar[XB_XGEN(b.x)]) == gen, bar);
            __builtin_amdgcn_fence(__ATOMIC_ACQUIRE, "agent");
            asm volatile("s_waitcnt vmcnt(0)" ::: "memory");
        }
    }
    __syncthreads();
}

constexpr int NWAVES = 8;
constexpr int BATCH = 16, SEQ = 4096, DM = 1024, M = BATCH * SEQ;
constexpr int NPROJ = 2592, NPAD = 2816;
constexpr int C_Q = 0, C_K = 256, C_V = 512, C_ZG = 1024, C_U = 1536, C_ZF = 2048, C_GF = 2560, C_GB = 2576;
constexpr float LN_EPS = 1e-5f, RMS_EPS = 1e-6f;
constexpr float DN_ALPHA = 1.189207115002721f;
constexpr float FN_SCALE = 0.0013810679320049757f;

constexpr size_t MiB = 1u << 20;
constexpr size_t WS_CTL = 0, CTL_ZERO_BYTES = 1 * MiB;
constexpr size_t WS_WIN = 2 * MiB;
constexpr size_t WS_WOUT = 8 * MiB;
constexpr size_t WS_CW = 10 * MiB;
constexpr size_t WS_XB = 16 * MiB;
constexpr size_t WS_PR = 144 * MiB;
constexpr size_t WS_MIX = 496 * MiB;
constexpr size_t WS_AP = 624 * MiB, WS_BP = 688 * MiB;
constexpr size_t WS_YR = 752 * MiB, WS_YI = 816 * MiB;
constexpr size_t WS_OF = 880 * MiB, WS_OB = 944 * MiB;
constexpr size_t WS_END = 1008 * MiB;
constexpr int CW_TMO = 0, CW_CODE = 1, CW_BAR = 4096;

constexpr int RING_BYTES = 131072, LDSCTL_OFF = RING_BYTES, MISC_OFF = LDSCTL_OFF + 320, LDS_BYTES = 147456;

__device__ __forceinline__ float bf2f(unsigned short h) { return __uint_as_float((unsigned)h << 16); }
__device__ __forceinline__ float wave_sum(float v) {
#pragma unroll
    for (int o = 1; o < 64; o <<= 1) v += __shfl_xor(v, o);
    return v;
}
__device__ __forceinline__ float silu_f(float z) { return z / (1.f + __expf(-z)); }

struct Frame {
    LAS unsigned char* lds;
    volatile LAS unsigned* MISC;
    gu32* ctl;
    int tid, lane, wave, G;
    const float *x, *w_in, *wgu_f, *bg_f, *wgu_b, *bg_b, *gng, *w_fnet, *w_out, *ln_g, *ln_b;
    float* out;
    bf16 *WIN, *WOUT, *XB, *PR, *MIX, *AP, *BP, *YR, *YI, *OF, *OB;
    float *CW, *SW;
};

__device__ __forceinline__ void p0_transpose_item(const float* W, int K, int N, bf16* WT, int k0, int n0, int drow0, float sc, LAS float* scr, int lane) {
#pragma unroll 8
    for (int i = 0; i < 32; ++i) { const int kk = 2 * i + (lane >> 5); scr[kk * 33 + (lane & 31)] = W[(size_t)(k0 + kk) * N + n0 + (lane & 31)] * sc; }
    LDS_WAIT(); asm volatile("" ::: "memory");
    const int c = lane & 7;
#pragma unroll
    for (int j = 0; j < 4; ++j) { const int n = (lane >> 3) + 8 * j; const LAS float* s = scr + (8 * c) * 33 + n;
        v4u o; o.x = pk2(s[0 * 33], s[1 * 33]); o.y = pk2(s[2 * 33], s[3 * 33]); o.z = pk2(s[4 * 33], s[5 * 33]); o.w = pk2(s[6 * 33], s[7 * 33]);
        *(GAS v4u*)(WT + (size_t)(drow0 + n) * K + k0 + 8 * c) = o; }
    LDS_WAIT(); asm volatile("" ::: "memory");
}

__device__ __forceinline__ void ph_prep(Frame& F) {
    LAS float* scr = (LAS float*)(F.lds + F.wave * 16384);
    const int gw = blockIdx.x * NWAVES + F.wave, NGW = F.G * NWAVES;
    constexpr int NB_IN = NPROJ / 32, I_IN = (DM / 64) * NB_IN, I_OUT = (DM / 64) * (DM / 32);
    for (int it = gw; it < I_IN + I_OUT; it += NGW) {
        if (it < I_IN) {
            const int kb = it / NB_IN, nb = it % NB_IN, n0 = nb * 32;
            const int drow0 = (n0 < 1024) ? n0 : (n0 == 1024 ? C_GF : n0 - 32);
            p0_transpose_item(F.w_in, DM, NPROJ, F.WIN, kb * 64, n0, drow0, (n0 < 256) ? 0.125f : 1.f, scr, F.lane);
        } else {
            const int r = it - I_IN, kb = r / (DM / 32), nb = r % (DM / 32);
            p0_transpose_item(F.w_out, DM, DM, F.WOUT, kb * 64, nb * 32, nb * 32, 1.f, scr, F.lane);
        }
    }
    const int gt = blockIdx.x * (NWAVES * 64) + F.tid, NGT = F.G * NWAVES * 64;
    for (int i = gt; i < (NPAD - NPROJ) * DM / 8; i += NGT) ((GAS v4u*)(F.WIN + (size_t)NPROJ * DM))[i] = (v4u){0u, 0u, 0u, 0u};
    for (size_t i = gt; i < (size_t)M * DM / 8; i += NGT) {
        const f32x4 a = ((const GAS f32x4*)F.x)[2 * i], b = ((const GAS f32x4*)F.x)[2 * i + 1];
        v4u o; o.x = pk2(a.x, a.y); o.y = pk2(a.z, a.w); o.z = pk2(b.x, b.y); o.w = pk2(b.z, b.w);
        ((GAS v4u*)F.XB)[i] = o;
    }
    for (int i = gt; i < 4 * 128 * 128; i += NGT) {
        const int d = i & 127, c = (i >> 7) & 127, g = i >> 14;
        float sc_ = 0.f, ss_ = 0.f;
        for (int k = 0; k < 128; ++k) { float sn, cs; sincospif((float)((c * k) & 127) * (1.f / 64.f), &sn, &cs); const float w = F.w_fnet[(g * 128 + k) * 128 + d]; sc_ += cs * w; ss_ += sn * w; }
        F.CW[i] = sc_; F.SW[i] = ss_;
    }
}

__device__ __forceinline__ void ph_t1(Frame& F) {
    float* us = (float*)(unsigned char*)F.lds;
    const int tid = F.tid, d = tid & 127, rq = tid >> 7;
    for (int it = blockIdx.x; it < (M / 32) * 4; it += F.G) {
        const int g = it & 3, row0 = (it >> 2) * 32;
        { const int r = tid >> 4, sg = tid & 15;
          const v4u raw = *(const GAS v4u*)(F.PR + (size_t)(row0 + r) * NPAD + C_U + g * 128 + sg * 8);
          float* o = us + r * 128 + sg * 8;
          o[0] = __uint_as_float(raw.x << 16); o[1] = __uint_as_float(raw.x & 0xffff0000u); o[2] = __uint_as_float(raw.y << 16); o[3] = __uint_as_float(raw.y & 0xffff0000u);
          o[4] = __uint_as_float(raw.z << 16); o[5] = __uint_as_float(raw.z & 0xffff0000u); o[6] = __uint_as_float(raw.w << 16); o[7] = __uint_as_float(raw.w & 0xffff0000u); }
        __syncthreads();
        float aA[8], aB[8];
#pragma unroll
        for (int r = 0; r < 8; ++r) { aA[r] = 0.f; aB[r] = 0.f; }
        const float* cw = F.CW + g * 16384 + d; const float* sw = F.SW + g * 16384 + d;
        for (int c = 0; c < 128; ++c) { const float w1 = cw[c * 128], w2 = sw[c * 128];
#pragma unroll
            for (int r = 0; r < 8; ++r) { const float uu = us[(rq * 8 + r) * 128 + c]; aA[r] += uu * w1; aB[r] += uu * w2; } }
#pragma unroll
        for (int r = 0; r < 8; ++r) { const size_t o = (size_t)(row0 + rq * 8 + r) * 512 + g * 128 + d; F.AP[o] = (bf16)f2bf(aA[r]); F.BP[o] = (bf16)f2bf(aB[r]); }
        __syncthreads();
    }
}

__device__ __forceinline__ void ph_s1(Frame& F) {
    float* cs = (float*)(unsigned char*)F.lds; float* sn = cs + 64;
    if (F.tid < 64) { float s, c; sincospif((float)F.tid * (1.f / 32.f), &s, &c); cs[F.tid] = c; sn[F.tid] = s; }
    __syncthreads();
    const int col = F.tid;
    for (int it = blockIdx.x; it < BATCH * 64; it += F.G) {
        const int b = it >> 6, n2 = it & 63;
        float za[64], zb[64];
#pragma unroll
        for (int n1 = 0; n1 < 64; ++n1) { const size_t o = (size_t)(b * SEQ + 64 * n1 + n2) * 512 + col; za[n1] = bf2f(F.AP[o]); zb[n1] = bf2f(F.BP[o]); }
        for (int k1 = 0; k1 < 64; ++k1) {
            float yr = 0.f, yi = 0.f;
#pragma unroll
            for (int n1 = 0; n1 < 64; ++n1) { const int ix = (k1 * n1) & 63; const float c = cs[ix], s = sn[ix]; yr += za[n1] * c - zb[n1] * s; yi -= zb[n1] * c + za[n1] * s; }
            float ts, tc; sincospif((float)(n2 * k1) * (1.f / 2048.f), &ts, &tc);
            const float pr = yr * tc + yi * ts, pi = yi * tc - yr * ts;
            const size_t o = (size_t)(b * SEQ + k1 * 64 + n2) * 512 + col; F.YR[o] = (bf16)f2bf(pr); F.YI[o] = (bf16)f2bf(pi);
        }
    }
}

__device__ __forceinline__ void ph_s2(Frame& F) {
    float* cs = (float*)(unsigned char*)F.lds; float* sn = cs + 64;
    if (F.tid < 64) { float s, c; sincospif((float)F.tid * (1.f / 32.f), &s, &c); cs[F.tid] = c; sn[F.tid] = s; }
    __syncthreads();
    const int col = F.tid;
    for (int it = blockIdx.x; it < BATCH * 64; it += F.G) {
        const int b = it >> 6, k1 = it & 63;
        float yr[64], yi[64];
#pragma unroll
        for (int n2 = 0; n2 < 64; ++n2) { const size_t o = (size_t)(b * SEQ + k1 * 64 + n2) * 512 + col; yr[n2] = bf2f(F.YR[o]); yi[n2] = bf2f(F.YI[o]); }
        for (int k2 = 0; k2 < 64; ++k2) {
            float x = 0.f;
#pragma unroll
            for (int n2 = 0; n2 < 64; ++n2) { const int ix = (k2 * n2) & 63; x += yr[n2] * cs[ix] + yi[n2] * sn[ix]; }
            const size_t row = (size_t)(b * SEQ + k1 + 64 * k2);
            const float z = bf2f(F.PR[row * NPAD + C_ZF + col]);
            F.MIX[row * DM + 512 + col] = (bf16)f2bf(x * FN_SCALE * silu_f(z));
        }
    }
}


namespace gla {
constexpr int RS = 144;
constexpr int TILE = 64 * RS;
constexpr int O_QT = 0, O_KT = TILE, O_KD = 2 * TILE, O_V = 3 * TILE, O_P = 4 * TILE, O_ST = 5 * TILE, O_LH = 6 * TILE, O_LL = 7 * TILE;
constexpr int O_BF = 8 * TILE, BRS = 272;
constexpr int O_END = O_BF + 64 * BRS;
typedef short v4i16_t __attribute__((ext_vector_type(4)));
typedef unsigned u32x2 __attribute__((ext_vector_type(2)));
__device__ __forceinline__ bf16x8 ldfrag(const LAS unsigned char* p) { return *(const LAS bf16x8*)p; }
__device__ __forceinline__ bf16x8 trfrag(const LAS unsigned char* p) {
    const v4i16_t a = __builtin_amdgcn_ds_read_tr16_b64_v4i16((LAS v4i16_t*)p);
    const v4i16_t b = __builtin_amdgcn_ds_read_tr16_b64_v4i16((LAS v4i16_t*)(p + 4 * RS));
    return (bf16x8){a.x, a.y, a.z, a.w, b.x, b.y, b.z, b.w};
}
__device__ __forceinline__ f32x4 mma(bf16x8 a, bf16x8 b, f32x4 c) { return __builtin_amdgcn_mfma_f32_16x16x32_bf16(a, b, c, 0, 0, 0); }
}

__device__ __forceinline__ void ph_gla(Frame& F) {
    using namespace gla;
    LAS unsigned char* L = F.lds;
    const int tid = F.tid, lane = F.lane, w = F.wave;
    const int c = lane & 15, g = lane >> 4, q4 = (lane & 15) >> 2, p4 = lane & 3;
    const int mrow = w >> 1, nb = 2 * (w & 1);
    const int ri = tid >> 3, seg = tid & 7;
    const f32x4 zero4 = {0.f, 0.f, 0.f, 0.f};
    bf16x8 lfr[2];
#pragma unroll
    for (int ks = 0; ks < 2; ++ks)
#pragma unroll
        for (int e = 0; e < 8; ++e) lfr[ks][e] = (32 * ks + 8 * g + e <= 16 * mrow + c) ? (short)0x3F80 : (short)0;
    for (int it = blockIdx.x; it < BATCH * 4 * 2 * 2; it += F.G) {
        const int vs = it & 1, dir = (it >> 1) & 1, h = (it >> 2) & 3, b = it >> 4;
        const float* wg = dir ? F.wgu_b : F.wgu_f; const float* bg = dir ? F.bg_b : F.bg_f;
        bf16* O = dir ? F.OB : F.OF;
        bf16x8 wub[2]; float bias2[2];
#pragma unroll
        for (int t = 0; t < 2; ++t) { const int col = 64 * h + 16 * (nb + t) + c; bias2[t] = bg[col];
#pragma unroll
            for (int e = 0; e < 8; ++e) wub[t][e] = (g < 2) ? (short)f2bf(wg[(8 * g + e) * 256 + col]) : (short)0; }
        __syncthreads();
        for (int i = tid; i < TILE / 4; i += NWAVES * 64) ((LAS unsigned*)(L + O_ST))[i] = 0u;
        f32x4 Sacc[2] = {zero4, zero4};
        v4u cq, ck, cv, cg;
        { const int tok = dir ? (SEQ - 1 - ri) : ri; const bf16* rp = F.PR + (size_t)(b * SEQ + tok) * NPAD;
          cq = *(const GAS v4u*)(rp + C_Q + 64 * h + 8 * seg); ck = *(const GAS v4u*)(rp + C_K + 64 * h + 8 * seg); cv = *(const GAS v4u*)(rp + C_V + 128 * h + 64 * vs + 8 * seg);
          const int r2 = 16 * mrow + c, tok2 = dir ? (SEQ - 1 - r2) : r2;
          cg = (v4u){0u, 0u, 0u, 0u}; if (g < 2) cg = *(const GAS v4u*)(F.PR + (size_t)(b * SEQ + tok2) * NPAD + C_GF + 16 * dir + 8 * g); }
        for (int blk = 0; blk < 64; ++blk) {
            v4u nq = cq, nk = ck, nv = cv, ng = cg;
            if (blk + 1 < 64) { const int r1 = (blk + 1) * 64 + ri, tok = dir ? (SEQ - 1 - r1) : r1; const bf16* rp = F.PR + (size_t)(b * SEQ + tok) * NPAD;
                nq = *(const GAS v4u*)(rp + C_Q + 64 * h + 8 * seg); nk = *(const GAS v4u*)(rp + C_K + 64 * h + 8 * seg); nv = *(const GAS v4u*)(rp + C_V + 128 * h + 64 * vs + 8 * seg);
                const int r2 = (blk + 1) * 64 + 16 * mrow + c, tok2 = dir ? (SEQ - 1 - r2) : r2;
                ng = (v4u){0u, 0u, 0u, 0u}; if (g < 2) ng = *(const GAS v4u*)(F.PR + (size_t)(b * SEQ + tok2) * NPAD + C_GF + 16 * dir + 8 * g); }
            { const bf16x8 ga = __builtin_bit_cast(bf16x8, cg);
#pragma unroll
              for (int t = 0; t < 2; ++t) { const f32x4 pre = mma(ga, wub[t], zero4); unsigned hh[4], ll[4];
#pragma unroll
                  for (int r = 0; r < 4; ++r) { const float x = pre[r] + bias2[t]; const float la = (fminf(x, 0.f) - __logf(1.f + __expf(-fabsf(x)))) * (1.f / 16.f);
                      hh[r] = f2bf(la); ll[r] = f2bf(la - __uint_as_float(hh[r] << 16)); }
                  const int off = (16 * (nb + t) + c) * RS + (16 * mrow + 4 * g) * 2;
                  *(LAS u32x2*)(L + O_LH + off) = (u32x2){hh[0] | (hh[1] << 16), hh[2] | (hh[3] << 16)};
                  *(LAS u32x2*)(L + O_LL + off) = (u32x2){ll[0] | (ll[1] << 16), ll[2] | (ll[3] << 16)}; } }
            __syncthreads();
#pragma unroll
            for (int t = 0; t < 2; ++t) { const int md = nb + t; f32x4 acc = zero4;
                const LAS unsigned char* ah = L + O_LH + (16 * md + c) * RS + 16 * g; const LAS unsigned char* al = L + O_LL + (16 * md + c) * RS + 16 * g;
                acc = mma(ldfrag(ah), lfr[0], acc); acc = mma(ldfrag(al), lfr[0], acc);
                if (mrow >= 2) { acc = mma(ldfrag(ah + 64), lfr[1], acc); acc = mma(ldfrag(al + 64), lfr[1], acc); }
                *(LAS f32x4*)(L + O_BF + (16 * mrow + c) * BRS + (16 * md + 4 * g) * 4) = acc; }
            __syncthreads();
            { const f32x4 b0 = *(const LAS f32x4*)(L + O_BF + ri * BRS + seg * 32), b1 = *(const LAS f32x4*)(L + O_BF + ri * BRS + seg * 32 + 16);
              const f32x4 l0 = *(const LAS f32x4*)(L + O_BF + 63 * BRS + seg * 32), l1 = *(const LAS f32x4*)(L + O_BF + 63 * BRS + seg * 32 + 16);
              float bb[8] = {b0[0], b0[1], b0[2], b0[3], b1[0], b1[1], b1[2], b1[3]}; float bl[8] = {l0[0], l0[1], l0[2], l0[3], l1[0], l1[1], l1[2], l1[3]};
              const unsigned qw[4] = {cq.x, cq.y, cq.z, cq.w}, kw[4] = {ck.x, ck.y, ck.z, ck.w};
              unsigned oq[4], ok[4], od[4];
#pragma unroll
              for (int e = 0; e < 4; ++e) {
                  const float q0 = __uint_as_float(qw[e] << 16), q1 = __uint_as_float(qw[e] & 0xffff0000u), k0 = __uint_as_float(kw[e] << 16), k1 = __uint_as_float(kw[e] & 0xffff0000u);
                  const float x0 = bb[2 * e], x1 = bb[2 * e + 1];
                  oq[e] = pk2(q0 * __expf(x0), q1 * __expf(x1)); ok[e] = pk2(k0 * __expf(-x0), k1 * __expf(-x1));
                  od[e] = pk2(k0 * __expf(bl[2 * e] - x0), k1 * __expf(bl[2 * e + 1] - x1)); }
              *(LAS v4u*)(L + O_QT + ri * RS + seg * 16) = (v4u){oq[0], oq[1], oq[2], oq[3]};
              *(LAS v4u*)(L + O_KT + ri * RS + seg * 16) = (v4u){ok[0], ok[1], ok[2], ok[3]};
              *(LAS v4u*)(L + O_KD + ri * RS + seg * 16) = (v4u){od[0], od[1], od[2], od[3]};
              *(LAS v4u*)(L + O_V + ri * RS + seg * 16) = cv; }
            __syncthreads();
            f32x4 oacc[2];
            { const bf16x8 qb0 = ldfrag(L + O_QT + (16 * mrow + c) * RS + 16 * g), qb1 = ldfrag(L + O_QT + (16 * mrow + c) * RS + 64 + 16 * g);
#pragma unroll
              for (int t = 0; t < 2; ++t) { const int mj = nb + t; f32x4 pt = zero4;
                  if (mj <= mrow) { const LAS unsigned char* ka = L + O_KT + (16 * mj + c) * RS + 16 * g; pt = mma(ldfrag(ka), qb0, pt); pt = mma(ldfrag(ka + 64), qb1, pt); }
                  float pm[4];
#pragma unroll
                  for (int r = 0; r < 4; ++r) pm[r] = (16 * mj + 4 * g + r <= 16 * mrow + c) ? pt[r] : 0.f;
                  *(LAS u32x2*)(L + O_P + (16 * mrow + c) * RS + (16 * mj + 4 * g) * 2) = (u32x2){pk2(pm[0], pm[1]), pk2(pm[2], pm[3])};
                  const LAS unsigned char* sa = L + O_ST + (16 * mj + c) * RS + 16 * g;
                  oacc[t] = mma(ldfrag(sa), qb0, zero4); oacc[t] = mma(ldfrag(sa + 64), qb1, oacc[t]); } }
            __syncthreads();
            { const bf16x8 pb0 = ldfrag(L + O_P + (16 * mrow + c) * RS + 16 * g);
              bf16x8 pb1 = pb0; if (mrow >= 2) pb1 = ldfrag(L + O_P + (16 * mrow + c) * RS + 64 + 16 * g);
              const int r2 = blk * 64 + 16 * mrow + c, tok = dir ? (SEQ - 1 - r2) : r2;
              bf16* orow = O + (size_t)(b * SEQ + tok) * 512 + 128 * h + 64 * vs;
#pragma unroll
              for (int t = 0; t < 2; ++t) { const int mv = nb + t; const LAS unsigned char* va = L + O_V + (8 * g + q4) * RS + (16 * mv + 4 * p4) * 2;
                  oacc[t] = mma(trfrag(va), pb0, oacc[t]);
                  if (mrow >= 2) oacc[t] = mma(trfrag(va + 32 * RS), pb1, oacc[t]);
                  *(GAS u32x2*)(orow + 16 * mv + 4 * g) = (u32x2){pk2(oacc[t][0], oacc[t][1]), pk2(oacc[t][2], oacc[t][3])}; }
              const f32x4 blv = *(const LAS f32x4*)(L + O_BF + 63 * BRS + (16 * mrow + 4 * g) * 4);
              const f32x4 dec = {__expf(blv[0]), __expf(blv[1]), __expf(blv[2]), __expf(blv[3])};
              const LAS unsigned char* kda = L + O_KD + (8 * g + q4) * RS + (16 * mrow + 4 * p4) * 2;
              const bf16x8 ka0 = trfrag(kda), ka1 = trfrag(kda + 32 * RS);
#pragma unroll
              for (int t = 0; t < 2; ++t) { const int nv_ = nb + t; const LAS unsigned char* vb = L + O_V + (8 * g + q4) * RS + (16 * nv_ + 4 * p4) * 2;
                  f32x4 s = Sacc[t] * dec; s = mma(ka0, trfrag(vb), s); s = mma(ka1, trfrag(vb + 32 * RS), s); Sacc[t] = s;
                  *(LAS u32x2*)(L + O_ST + (16 * nv_ + c) * RS + (16 * mrow + 4 * g) * 2) = (u32x2){pk2(s[0], s[1]), pk2(s[2], s[3])}; } }
            cq = nq; ck = nk; cv = nv; cg = ng;
        }
    }
}

__device__ __forceinline__ void ph_mixbuild(Frame& F) {
    const int gw = blockIdx.x * NWAVES + F.wave, NGW = F.G * NWAVES, lane = F.lane;
    for (int it = gw; it < M * 4; it += NGW) {
        const int h = it & 3; const size_t row = (size_t)(it >> 2);
        const unsigned a = *(const GAS unsigned*)(F.OF + row * 512 + h * 128 + 2 * lane), b = *(const GAS unsigned*)(F.OB + row * 512 + h * 128 + 2 * lane);
        const unsigned zz = *(const GAS unsigned*)(F.PR + row * NPAD + C_ZG + h * 128 + 2 * lane);
        const float o0 = __uint_as_float(a << 16) + __uint_as_float(b << 16), o1 = __uint_as_float(a & 0xffff0000u) + __uint_as_float(b & 0xffff0000u);
        const float ss = wave_sum(o0 * o0 + o1 * o1);
        const float rstd = 1.0f / sqrtf(ss * (1.f / 128.f) + RMS_EPS);
        const float g0 = F.gng[h * 128 + 2 * lane], g1 = F.gng[h * 128 + 2 * lane + 1];
        const float m0 = o0 * rstd * g0 * silu_f(__uint_as_float(zz << 16)), m1 = o1 * rstd * g1 * silu_f(__uint_as_float(zz & 0xffff0000u));
        *(GAS unsigned*)(F.MIX + row * DM + h * 128 + 2 * lane) = pk2(m0, m1);
    }
}

__device__ __forceinline__ void ph_ln(Frame& F, bool bad) {
    const int gw = blockIdx.x * NWAVES + F.wave, NGW = F.G * NWAVES;
    const float qnan = __builtin_nanf("");
    for (int m = gw; m < M; m += NGW) {
        GAS f32x4* xr = (GAS f32x4*)(F.out + (size_t)m * DM) + F.lane;
        f32x4 v[4]; float s = 0.f;
#pragma unroll
        for (int j = 0; j < 4; ++j) { v[j] = xr[64 * j]; s += (v[j].x + v[j].y) + (v[j].z + v[j].w); }
        const float mean = wave_sum(s) * (1.f / DM); float s2 = 0.f;
#pragma unroll
        for (int j = 0; j < 4; ++j) { v[j] = v[j] - mean; s2 += (v[j].x * v[j].x + v[j].y * v[j].y) + (v[j].z * v[j].z + v[j].w * v[j].w); }
        const float rstd = 1.f / sqrtf(wave_sum(s2) * (1.f / DM) + LN_EPS);
#pragma unroll
        for (int j = 0; j < 4; ++j) { const f32x4 g = ((const GAS f32x4*)F.ln_g)[F.lane + 64 * j], bb = ((const GAS f32x4*)F.ln_b)[F.lane + 64 * j];
            f32x4 o = v[j] * rstd * g + bb; if (bad) o = (f32x4){qnan, qnan, qnan, qnan}; xr[64 * j] = o; }
    }
}

constexpr int N_PHASES = 9;
#ifndef MK_N_LAUNCHES
#define MK_N_LAUNCHES 1
#endif
struct Args { const float* in[11]; float* out; unsigned char* ws; int ph_lo, ph_hi, li, pad; };
__global__ void __launch_bounds__(NWAVES * 64, 2) fwd_kernel(Args args) {
    extern __shared__ __attribute__((aligned(16))) unsigned char lds[];
    Frame F;
    F.lds = (LAS unsigned char*)lds;
    F.MISC = (volatile LAS unsigned*)(F.lds + MISC_OFF);
    F.tid = threadIdx.x; F.lane = F.tid & 63; F.wave = __builtin_amdgcn_readfirstlane(F.tid >> 6); F.G = gridDim.x;
    unsigned char* ws = args.ws;
    F.ctl = (gu32*)(ws + WS_CTL);
    F.x = args.in[0]; F.w_in = args.in[1]; F.wgu_f = args.in[2]; F.bg_f = args.in[3]; F.wgu_b = args.in[4]; F.bg_b = args.in[5];
    F.gng = args.in[6]; F.w_fnet = args.in[7]; F.w_out = args.in[8]; F.ln_g = args.in[9]; F.ln_b = args.in[10]; F.out = args.out;
    F.WIN = (bf16*)(ws + WS_WIN); F.WOUT = (bf16*)(ws + WS_WOUT); F.XB = (bf16*)(ws + WS_XB); F.PR = (bf16*)(ws + WS_PR); F.MIX = (bf16*)(ws + WS_MIX);
    F.AP = (bf16*)(ws + WS_AP); F.BP = (bf16*)(ws + WS_BP); F.YR = (bf16*)(ws + WS_YR); F.YI = (bf16*)(ws + WS_YI); F.OF = (bf16*)(ws + WS_OF); F.OB = (bf16*)(ws + WS_OB);
    F.CW = (float*)(ws + WS_CW); F.SW = F.CW + 4 * 128 * 128;
    for (int u = F.tid; u < (LDS_BYTES - LDSCTL_OFF) / 4; u += NWAVES * 64) ((LAS unsigned*)(F.lds + LDSCTL_OFF))[u] = 0u;
    __syncthreads();
    const int lo = args.ph_lo, hi = args.ph_hi;
    const bool use_bar = (hi - lo) > 1;
    XcdBarrier bar; bar.bar = (unsigned*)(F.ctl + CW_BAR) + args.li * XCD_BAR_WORDS; bar.x = 0; bar.st = nullptr;
    if (use_bar) bar = xcd_barrier_post((unsigned*)(F.ctl + CW_BAR) + args.li * XCD_BAR_WORDS, F.MISC + 8);
#define IN(k) (lo <= (k) && (k) < hi)
#define SEAM(k) do { if (IN(k) && IN((k) + 1)) xcd_barrier(bar); } while (0)
    if (IN(0)) { ph_prep(F); SEAM(0); }
    if (IN(1)) {
        pg8::Gemm g{F.XB, F.WIN, M, NPAD, DM}; pg8::StaticOrder S; S.init(M, NPAD, F.G, (int)blockIdx.x);
        pg8::EpiBf16<0> E{F.PR, NPAD, nullptr, 0, 0, 1.f};
        pg8::gemm_phase<pg8::EpiBf16<0>, pg8::StaticOrder, true, true>(F.lds, g, S, E);
        SEAM(1);
    }
    if (IN(2)) { ph_t1(F); SEAM(2); }
    if (IN(3)) { ph_s1(F); SEAM(3); }
    if (IN(4)) { ph_gla(F); SEAM(4); }
    if (IN(5)) { ph_s2(F); SEAM(5); }
    if (IN(6)) { ph_mixbuild(F); SEAM(6); }
    if (IN(7)) {
        pg8::Gemm g{F.MIX, F.WOUT, M, DM, DM}; pg8::StaticOrder S; S.init(M, DM, F.G, (int)blockIdx.x);
        pg8::EpiResF32 E{F.x, F.out, DM, DN_ALPHA};
        pg8::gemm_phase<pg8::EpiResF32, pg8::StaticOrder, true, true>(F.lds, g, S, E);
        SEAM(7);
    }
    if (IN(8)) {
        bool bad = (__hip_atomic_load(F.ctl + CW_TMO, RLX_AGENT) != 0u);
        for (int li = 0; li < 3; ++li) bad |= __hip_atomic_load((gu32*)((const unsigned*)(F.ctl + CW_BAR) + XB_TMO) + li * XCD_BAR_WORDS, RLX_AGENT) != 0u;
        ph_ln(F, bad);
    }
#undef IN
#undef SEAM
}

extern "C" void kernel_launch(void* const* d_in, const int* in_sizes, int n_in, void* d_out, int out_size, void* d_ws, size_t ws_size, hipStream_t stream) {
    static int grid = 0;
    if (grid == 0) {
        if (n_in != 11 || in_sizes[0] != M * DM || out_size != M * DM || ws_size < WS_END) { fprintf(stderr, "kernel_launch: unexpected shapes: n_in %d in0 %d out %d ws %zu (need %zu)\n", n_in, n_in > 0 ? in_sizes[0] : -1, out_size, ws_size, (size_t)WS_END); grid = -1; return; }
        int dev = 0, cus = 0, per_cu = 0;
        if (hipGetDevice(&dev) != hipSuccess || hipDeviceGetAttribute(&cus, hipDeviceAttributeMultiprocessorCount, dev) != hipSuccess) { grid = -1; return; }
        if (hipFuncSetAttribute((const void*)fwd_kernel, hipFuncAttributeMaxDynamicSharedMemorySize, LDS_BYTES) != hipSuccess) { fprintf(stderr, "kernel_launch: hipFuncSetAttribute failed\n"); grid = -1; return; }
        if (hipOccupancyMaxActiveBlocksPerMultiprocessor(&per_cu, (const void*)fwd_kernel, NWAVES * 64, LDS_BYTES) != hipSuccess || per_cu < 1) { fprintf(stderr, "kernel_launch: occupancy query says %d blocks/CU\n", per_cu); per_cu = 1; }
        (void)hipGetLastError();
        grid = cus;
        if (grid > 256) grid = 256;
    }
    if (grid < 0) return;
    if (hipMemsetAsync((char*)d_ws + WS_CTL, 0, CTL_ZERO_BYTES, stream) != hipSuccess) { fprintf(stderr, "kernel_launch: memset failed\n"); return; }
    Args a{};
    for (int i = 0; i < 11; ++i) a.in[i] = (const float*)d_in[i];
    a.out = (float*)d_out; a.ws = (unsigned char*)d_ws;
    constexpr int NL = MK_N_LAUNCHES;
    for (int li = 0; li < NL; ++li) {
        if (NL == 1) { a.ph_lo = 0; a.ph_hi = N_PHASES; } else { a.ph_lo = li; a.ph_hi = li + 1; }
        a.li = (NL == 1) ? 0 : 0;
        hipLaunchKernelGGL(fwd_kernel, dim3(grid), dim3(NWAVES * 64), LDS_BYTES, stream, a);
        const hipError_t le = hipPeekAtLastError();
        if (le != hipSuccess) { fprintf(stderr, "kernel_launch: launch %d failed: %s\n", li, hipGetErrorName(le)); break; }
    }
}
```

```cpp
#include <hip/hip_runtime.h>
#include <cstdio>
#include <cstdint>
namespace pg8 {
#define PG8_LAS __attribute__((address_space(3)))
typedef unsigned short bf16_t;
typedef short bf16x8 __attribute__((ext_vector_type(8)));
typedef float f32x4 __attribute__((ext_vector_type(4)));
typedef unsigned u32x4 __attribute__((ext_vector_type(4)));
constexpr int BM = 256, BK = 64, HALF = 128, HTB = HALF * BK * 2  , STAGE_BYTES = 8 * HTB, NXCD = 8, WGM = 8;

__host__ __device__ __forceinline__ int lds_byte(int r, int c) { const int st = (r >> 4) * 2 + (c >> 5), rr = r & 15, cc = c & 31, ob = rr * 64 + cc * 2; return st * 1024 + (ob ^ (((ob >> 9) & 1) << 5)); }
__host__ __device__ __forceinline__ void stage_rc(int b, int& R, int& C) { const int st = b / 1024, sb = b % 1024, swz = sb ^ (((sb >> 9) & 1) << 5); R = (st >> 1) * 16 + swz / 64; C = (st & 1) * 32 + (swz % 64) / 2; }
__host__ __device__ __forceinline__ int perm32(int rho) { const int n = rho >> 4, i = rho & 15; return 8 * (i >> 2) + 4 * n + (i & 3); }

struct Unit { int pm, pn; };
struct Gemm { const bf16_t* A; const bf16_t* Bt; int M, N, K; };

struct StaticOrder {
    int nM, nN, nwg, G, c;
    __host__ __device__ void init(int M, int N, int G_, int c_) { nM = M / BM; nN = N / BM; nwg = nM * nN; G = G_; c = c_; }
    __host__ __device__ bool next(int i, Unit& u) const {
        const long L = (long)i * G + c; if (L >= nwg) return false;
        int wgid = (int)L; { const int q = nwg / NXCD, r = nwg % NXCD, xcd = wgid % NXCD, off = wgid / NXCD; wgid = (xcd < r ? xcd * (q + 1) : r * (q + 1) + (xcd - r) * q) + off; }
        const int nig = WGM * nN, gid = wgid / nig, fm = gid * WGM, gsz = (nM - fm) < WGM ? (nM - fm) : WGM;
        u.pm = fm + ((wgid % nig) % gsz); u.pn = (wgid % nig) / gsz; return true;
    }
    __device__ __forceinline__ void a_ready(const Unit&) const {}
    __device__ __forceinline__ void done(const Unit&) const {}
};

__device__ __forceinline__ unsigned cvt_pk_bf16(float lo, float hi) { unsigned r; asm volatile("v_cvt_pk_bf16_f32 %0, %1, %2" : "=v"(r) : "v"(lo), "v"(hi)); return r; }
typedef float f32x2 __attribute__((ext_vector_type(2)));
__device__ __forceinline__ f32x2 gelu_pk(f32x2 v) {
    const f32x2 av = __builtin_elementwise_abs(v), d = av * 0.2316418882f + 1.0f;
    f32x2 t; t.x = __builtin_amdgcn_rcpf(d.x); t.y = __builtin_amdgcn_rcpf(d.y);
    f32x2 q = t * 0.5307027145f + (-0.7265760135f); q = q * t + 0.7107068705f; q = q * t + (-0.142248368f); q = q * t + 0.127414796f; q = q * t;
    const f32x2 s = (v * v) * (-0.72134752044f);
    f32x2 e; e.x = __builtin_amdgcn_exp2f(s.x); e.y = __builtin_amdgcn_exp2f(s.y);
    const f32x2 m = v * (q * e), r = v - m;
    f32x2 o; o.x = v.x < 0.f ? m.x : r.x; o.y = v.y < 0.f ? m.y : r.y; return o;
}

template <int ACT  > struct EpiBf16 {
    static constexpr bool PERM = true, AFTER_DRAIN = false; static_assert(ACT == 0 || ACT == 1, "EpiBf16: ACT is 0 (none) or 1 (gelu_pk)");
    bf16_t* O; int ldc; const float* bias; int split_cols; size_t split_stride; float scale0;
    __device__ __forceinline__ void operator()(const f32x4 (&acc)[2][2][4][2], const Unit& u, int wr, int wc, int fr, int fq) const {
        const int row0 = u.pm * BM + wr * 64 + fr; int colt = u.pn * BM; bf16_t* base = O;
        float sc = 1.f; if (split_cols) { const int t = colt / split_cols; base += (size_t)t * split_stride; colt -= t * split_cols; if (t == 0) sc = scale0; }
        const int col0 = colt + wc * 32 + 8 * fq, bcol0 = u.pn * BM + wc * 32 + 8 * fq;
        f32x4 bv[2][2];
#pragma unroll
        for (int bj = 0; bj < 2; ++bj)
#pragma unroll
            for (int n = 0; n < 2; ++n) bv[bj][n] = bias ? *(const f32x4*)(bias + bcol0 + bj * HALF + 4 * n) : (f32x4){0.f, 0.f, 0.f, 0.f};
#pragma unroll
        for (int ai = 0; ai < 2; ++ai)
#pragma unroll
            for (int m = 0; m < 4; ++m) { bf16_t* rowp = base + (size_t)(row0 + ai * HALF + m * 16) * ldc + col0;
#pragma unroll
                for (int bj = 0; bj < 2; ++bj) { f32x4 v0 = acc[ai][bj][m][0] + bv[bj][0], v1 = acc[ai][bj][m][1] + bv[bj][1];
                    if (ACT == 1) { f32x2 a = gelu_pk((f32x2){v0[0], v0[1]}), b = gelu_pk((f32x2){v0[2], v0[3]}), c = gelu_pk((f32x2){v1[0], v1[1]}), d = gelu_pk((f32x2){v1[2], v1[3]});
                        v0 = (f32x4){a.x, a.y, b.x, b.y}; v1 = (f32x4){c.x, c.y, d.x, d.y}; }
                    v0 = v0 * sc; v1 = v1 * sc; u32x4 w; w.x = cvt_pk_bf16(v0[0], v0[1]); w.y = cvt_pk_bf16(v0[2], v0[3]); w.z = cvt_pk_bf16(v1[0], v1[1]); w.w = cvt_pk_bf16(v1[2], v1[3]);
                    *(u32x4*)(rowp + bj * HALF) = w; } }
    }
};

struct PanelStats {
    unsigned* xbuf;
    unsigned* cnt;
    unsigned* tmo;
    int ntn; float eps;
    unsigned code;
    __device__ __forceinline__ bool run(const f32x4 (&v)[2][2][4][2], const Unit& u, int wr, int wc, int fr, int fq, PG8_LAS unsigned char* lds, int wid, int lane) const {
        typedef float f32x2v __attribute__((ext_vector_type(2)));
        PG8_LAS f32x2v* P = (PG8_LAS f32x2v*)lds;
        PG8_LAS f32x2v* S = (PG8_LAS f32x2v*)(lds + 8192);
        PG8_LAS unsigned* flag = (PG8_LAS unsigned*)(lds + 8192 + 2048);
#pragma unroll
        for (int ai = 0; ai < 2; ++ai)
#pragma unroll
            for (int m = 0; m < 4; ++m) {
                float s = 0.f;
#pragma unroll
                for (int bj = 0; bj < 2; ++bj)
#pragma unroll
                    for (int n = 0; n < 2; ++n) { const f32x4 x = v[ai][bj][m][n]; s += (x[0] + x[1]) + (x[2] + x[3]); }
                s += __shfl_xor(s, 16); s += __shfl_xor(s, 32);
                const float mw = s * (1.0f / 64.0f); float q = 0.f;
#pragma unroll
                for (int bj = 0; bj < 2; ++bj)
#pragma unroll
                    for (int n = 0; n < 2; ++n) { const f32x4 d = v[ai][bj][m][n] - mw; q += (d[0] * d[0] + d[1] * d[1]) + (d[2] * d[2] + d[3] * d[3]); }
                q += __shfl_xor(q, 16); q += __shfl_xor(q, 32);
                if (fq == 0) P[(ai * HALF + wr * 64 + m * 16 + fr) * 4 + wc] = (f32x2v){mw, q};
            }
        asm volatile("s_waitcnt lgkmcnt(0)" ::: "memory"); __builtin_amdgcn_s_barrier(); asm volatile("" ::: "memory");
#if defined(BROKEN_EXCHANGE_NO_WAIT)
#warning BROKEN CONTROL BUILD: the row-statistics exchange does not wait; results are wrong by design
        if (blockIdx.x >= 64) { const long long t0_ = clock64(); while (clock64() - t0_ < 60000) __builtin_amdgcn_s_sleep(8); }
#endif
        const int row = wid * 32 + (lane & 31);
        if (lane < 32) {
            const f32x2v a = P[row * 4 + 0], b = P[row * 4 + 1], c = P[row * 4 + 2], d = P[row * 4 + 3];
            const float mt = (a.x + b.x + c.x + d.x) * 0.25f;
            const float da = a.x - mt, db = b.x - mt, dc = c.x - mt, dd = d.x - mt;
            const float m2 = (a.y + b.y) + (c.y + d.y) + 64.0f * ((da * da + db * db) + (dc * dc + dd * dd));
            unsigned long long* slot = (unsigned long long*)xbuf + ((size_t)(u.pm * BM + row) * 4 + u.pn);
            __hip_atomic_store(slot, ((unsigned long long)__float_as_uint(m2) << 32) | __float_as_uint(mt), __ATOMIC_RELAXED, __HIP_MEMORY_SCOPE_AGENT);
        }
        asm volatile("s_waitcnt vmcnt(0)" ::: "memory");
        if (lane == 0) __hip_atomic_fetch_add(cnt + 64 * u.pm, 1u, __ATOMIC_RELAXED, __HIP_MEMORY_SCOPE_AGENT);
        if (wid == 0) {
            bool dead = false; const unsigned long long t0 = __builtin_amdgcn_s_memrealtime(); const unsigned want = 8u * (unsigned)ntn;
            for (;;) {
#if defined(BROKEN_EXCHANGE_NO_WAIT)
                break;
#endif
                if ((unsigned)__builtin_amdgcn_readfirstlane(__hip_atomic_load(cnt + 64 * u.pm, __ATOMIC_RELAXED, __HIP_MEMORY_SCOPE_AGENT)) >= want) break;
                if (__builtin_amdgcn_s_memrealtime() - t0 > 2000000ull) {
                    if (lane == 0) { unsigned expect = 0u; __hip_atomic_compare_exchange_strong(tmo + 1, &expect, code | (unsigned)(u.pm & 0xff), __ATOMIC_RELAXED, __ATOMIC_RELAXED, __HIP_MEMORY_SCOPE_AGENT);
                                     __hip_atomic_store(tmo, 1u, __ATOMIC_RELAXED, __HIP_MEMORY_SCOPE_AGENT); }
                    dead = true; break; }
                __builtin_amdgcn_s_sleep(2);
            }
            __builtin_amdgcn_fence(__ATOMIC_ACQUIRE, "agent");
            if (lane == 0) flag[0] = dead ? 1u : 0u;
        }
        asm volatile("s_waitcnt vmcnt(0) lgkmcnt(0)" ::: "memory"); __builtin_amdgcn_s_barrier(); asm volatile("" ::: "memory");
        const bool bad = flag[0] != 0u;
        if (lane < 32) {
            const unsigned long long* slot = (const unsigned long long*)xbuf + (size_t)(u.pm * BM + row) * 4; float mt[4], m2[4]; float ms = 0.f;
#pragma unroll
            for (int t = 0; t < 4; ++t) { if (t < ntn) { const unsigned long long w = __hip_atomic_load(slot + t, __ATOMIC_RELAXED, __HIP_MEMORY_SCOPE_AGENT); mt[t] = __uint_as_float((unsigned)w); m2[t] = __uint_as_float((unsigned)(w >> 32)); } else { mt[t] = 0.f; m2[t] = 0.f; } ms += mt[t]; }
            const float mean = ms / (float)ntn; float q = 0.f;
#pragma unroll
            for (int t = 0; t < 4; ++t) if (t < ntn) { const float dm = mt[t] - mean; q += m2[t] + 256.0f * dm * dm; }
            S[row] = (f32x2v){mean, 1.0f / sqrtf(q / (256.0f * (float)ntn) + eps)};
        }
        asm volatile("s_waitcnt lgkmcnt(0)" ::: "memory"); __builtin_amdgcn_s_barrier(); asm volatile("" ::: "memory");
        return bad;
    }
};
struct EpiLnRes {
    static constexpr bool PERM = false, AFTER_DRAIN = true;
    const float* base; float* out; int ldc; const float* bias; PanelStats st; unsigned poison;
    __device__ __forceinline__ void fused(f32x4 (&acc)[2][2][4][2], const Unit& u, int wr, int wc, int fr, int fq, PG8_LAS unsigned char* lds, int wid, int lane) const {
        typedef float f32x2v __attribute__((ext_vector_type(2)));
        const PG8_LAS f32x2v* S = (const PG8_LAS f32x2v*)(lds + 8192);
        const int col0 = u.pn * BM + wc * 32 + 4 * fq;
#pragma unroll
        for (int bj = 0; bj < 2; ++bj)
#pragma unroll
            for (int n = 0; n < 2; ++n) { const f32x4 bv = bias ? *(const f32x4*)(bias + col0 + bj * HALF + n * 16) : (f32x4){0.f, 0.f, 0.f, 0.f};
#pragma unroll
                for (int ai = 0; ai < 2; ++ai)
#pragma unroll
                    for (int m = 0; m < 4; ++m) acc[ai][bj][m][n] += bv; }
        f32x4 pre[4][2][2];
#pragma unroll
        for (int m = 0; m < 4; ++m) { const size_t off = (size_t)(u.pm * BM + wr * 64 + m * 16 + fr) * ldc + col0;
#pragma unroll
            for (int bj = 0; bj < 2; ++bj)
#pragma unroll
                for (int n = 0; n < 2; ++n) pre[m][bj][n] = *(const f32x4*)(base + off + bj * HALF + n * 16); }
        const bool bad = st.run(acc, u, wr, wc, fr, fq, lds, wid, lane) || poison != 0u;
        const float qnan = __builtin_nanf("");
#pragma unroll
        for (int ai = 0; ai < 2; ++ai)
#pragma unroll
            for (int m = 0; m < 4; ++m) { const int r = ai * HALF + wr * 64 + m * 16 + fr; const f32x2v sr = S[r]; const size_t off = (size_t)(u.pm * BM + r) * ldc + col0;
#pragma unroll
                for (int bj = 0; bj < 2; ++bj)
#pragma unroll
                    for (int n = 0; n < 2; ++n) { const f32x4 bs = ai == 0 ? pre[m][bj][n] : *(const f32x4*)(base + off + bj * HALF + n * 16); f32x4 o = bs + (acc[ai][bj][m][n] - sr.x) * sr.y;
                        if (bad) o = (f32x4){qnan, qnan, qnan, qnan}; *(f32x4*)(out + off + bj * HALF + n * 16) = o; }
                if (m & 1) asm volatile("" ::: "memory"); }
    }
};
struct EpiLnResLn {
    static constexpr bool PERM = false, AFTER_DRAIN = true;
    const float* base; float* out; bf16_t* xn; int ldc; const float* bias; PanelStats st1, st2; unsigned poison;
    __device__ __forceinline__ void fused(f32x4 (&acc)[2][2][4][2], const Unit& u, int wr, int wc, int fr, int fq, PG8_LAS unsigned char* lds, int wid, int lane) const {
        typedef float f32x2v __attribute__((ext_vector_type(2))); typedef unsigned u32x2v __attribute__((ext_vector_type(2)));
        const PG8_LAS f32x2v* S = (const PG8_LAS f32x2v*)(lds + 8192);
        const int col0 = u.pn * BM + wc * 32 + 4 * fq;
#pragma unroll
        for (int bj = 0; bj < 2; ++bj)
#pragma unroll
            for (int n = 0; n < 2; ++n) { const f32x4 bv = bias ? *(const f32x4*)(bias + col0 + bj * HALF + n * 16) : (f32x4){0.f, 0.f, 0.f, 0.f};
#pragma unroll
                for (int ai = 0; ai < 2; ++ai)
#pragma unroll
                    for (int m = 0; m < 4; ++m) acc[ai][bj][m][n] += bv; }
        bool bad = st1.run(acc, u, wr, wc, fr, fq, lds, wid, lane) || poison != 0u;
        const float qnan = __builtin_nanf("");
#pragma unroll
        for (int ai = 0; ai < 2; ++ai)
#pragma unroll
            for (int m = 0; m < 4; ++m) { const int r = ai * HALF + wr * 64 + m * 16 + fr; const f32x2v sr = S[r]; const size_t off = (size_t)(u.pm * BM + r) * ldc + col0;
#pragma unroll
                for (int bj = 0; bj < 2; ++bj)
#pragma unroll
                    for (int n = 0; n < 2; ++n) { const f32x4 bs = *(const f32x4*)(base + off + bj * HALF + n * 16); acc[ai][bj][m][n] = bs + (acc[ai][bj][m][n] - sr.x) * sr.y; }
                asm volatile("" : "+v"(acc[ai][0][m][0]), "+v"(acc[ai][0][m][1]), "+v"(acc[ai][1][m][0]), "+v"(acc[ai][1][m][1]));
                if (m & 1) asm volatile("" ::: "memory"); }
        const bool bad1 = bad;
        bad = st2.run(acc, u, wr, wc, fr, fq, lds, wid, lane) || bad;
#pragma unroll
        for (int ai = 0; ai < 2; ++ai)
#pragma unroll
            for (int m = 0; m < 4; ++m) { const int r = ai * HALF + wr * 64 + m * 16 + fr; const f32x2v sr = S[r]; const size_t off = (size_t)(u.pm * BM + r) * ldc + col0;
#pragma unroll
                for (int bj = 0; bj < 2; ++bj)
#pragma unroll
                    for (int n = 0; n < 2; ++n) { const f32x4 x1 = acc[ai][bj][m][n]; *(f32x4*)(out + off + bj * HALF + n * 16) = bad1 ? (f32x4){qnan, qnan, qnan, qnan} : x1;
                        const f32x4 o = (x1 - sr.x) * sr.y; u32x2v w; w.x = cvt_pk_bf16(o[0], o[1]); w.y = cvt_pk_bf16(o[2], o[3]);
                        if (bad) { w.x = 0x7fc07fc0u; w.y = 0x7fc07fc0u; } *(u32x2v*)(xn + off + bj * HALF + n * 16) = w; }
                asm volatile("" ::: "memory"); }
    }
};


struct EpiResF32 {
    static constexpr bool PERM = false, AFTER_DRAIN = false;
    const float* base; float* out; int ldc; float alpha;
    __device__ __forceinline__ void operator()(const f32x4 (&acc)[2][2][4][2], const Unit& u, int wr, int wc, int fr, int fq) const {
        const int col0 = u.pn * BM + wc * 32 + 4 * fq;
#pragma unroll
        for (int ai = 0; ai < 2; ++ai)
#pragma unroll
            for (int m = 0; m < 4; ++m) { const size_t off = (size_t)(u.pm * BM + ai * HALF + wr * 64 + m * 16 + fr) * ldc + col0;
#pragma unroll
                for (int bj = 0; bj < 2; ++bj)
#pragma unroll
                    for (int n = 0; n < 2; ++n) { const f32x4 bs = *(const f32x4*)(base + off + bj * HALF + n * 16); *(f32x4*)(out + off + bj * HALF + n * 16) = bs * alpha + acc[ai][bj][m][n]; }
                if (m & 1) asm volatile("" ::: "memory"); }
    }
};
template <class Epi, class Sched, bool ALIGN_EPI = false, bool SP2 = false>
__device__ __forceinline__ void gemm_phase(PG8_LAS unsigned char* lds, const Gemm g, const Sched& S, const Epi& E) {
    const int tid = threadIdx.x, wid = __builtin_amdgcn_readfirstlane(tid >> 6), lane = tid & 63, wr = wid >> 2, wc = wid & 3, fr = lane & 15, fq = lane >> 4;
    const int K = g.K, nt = K / BK;
    unsigned voffA[2], voffB[2];
#pragma unroll
    for (int i = 0; i < 2; ++i) { int R, C; stage_rc(tid * 16 + i * 8192, R, C); const int Rb = Epi::PERM ? ((R & ~31) + perm32(R & 31)) : R;
        voffA[i] = (unsigned)(R * K + C) * 2u; voffB[i] = (unsigned)(Rb * K + C) * 2u; }
    const size_t kstep = (size_t)(BK * 2);
    const size_t hstep = (size_t)HALF * K * 2;
    const size_t tstep = 2 * hstep;
    const unsigned ldsw = (unsigned)wid * 1024u;
    const int aoff = lds_byte(wr * 64 + fr, fq * 8), boff = lds_byte(wc * 32 + fr, fq * 8);
#define PG8_SA(b, h) (((b) * 2 + (h)) * HTB)
#define PG8_SB(b, h) ((4 + (b) * 2 + (h)) * HTB)
#define PG8_STAGE(bufoff, gbase, voff) do { _Pragma("unroll") for (int _i = 0; _i < 2; ++_i) \
        __builtin_amdgcn_global_load_lds((const unsigned*)((const char*)(gbase) + (voff)[_i]), (PG8_LAS unsigned*)(lds + (bufoff) + ldsw + _i * 8192), 16, 0, 0); } while (0)
#define PG8_LDA(dst, b, h) do { _Pragma("unroll") for (int m = 0; m < 4; ++m) _Pragma("unroll") for (int k = 0; k < 2; ++k) dst[m][k] = *(const PG8_LAS bf16x8*)(lds + PG8_SA(b, h) + aoff + m * 2048 + k * 1024); } while (0)
#define PG8_LDB(dst, b, h) do { _Pragma("unroll") for (int n = 0; n < 2; ++n) _Pragma("unroll") for (int k = 0; k < 2; ++k) dst[n][k] = *(const PG8_LAS bf16x8*)(lds + PG8_SB(b, h) + boff + n * 2048 + k * 1024); } while (0)
#define PG8_MMA(ai, bj, At, Bt) do { __builtin_amdgcn_s_setprio(1); _Pragma("unroll") for (int m = 0; m < 4; ++m) _Pragma("unroll") for (int n = 0; n < 2; ++n) _Pragma("unroll") for (int k = 0; k < 2; ++k) \
        acc[ai][bj][m][n] = __builtin_amdgcn_mfma_f32_16x16x32_bf16(Bt[n][k], At[m][k], acc[ai][bj][m][n], 0, 0, 0); __builtin_amdgcn_s_setprio(0); } while (0)
#define PG8_WAIT_V(n) asm volatile("s_waitcnt vmcnt(" #n ")" ::: "memory")
#define PG8_WAIT_L(n) asm volatile("s_waitcnt lgkmcnt(" #n ")" ::: "memory")
#define PG8_BAR __builtin_amdgcn_s_barrier()
#define PG8_SCHED __builtin_amdgcn_sched_barrier(0)
    Unit cur, nxt; int ui = 0;
    if (!S.next(0, cur)) return;
    f32x4 acc[2][2][4][2];
#pragma unroll
    for (int a = 0; a < 2; ++a)
#pragma unroll
        for (int b = 0; b < 2; ++b)
#pragma unroll
            for (int m = 0; m < 4; ++m)
#pragma unroll
                for (int n = 0; n < 2; ++n) acc[a][b][m][n] = (f32x4){0.f, 0.f, 0.f, 0.f};
    bf16x8 At[4][2], B0[2][2], B1[2][2];
    const char* cA = (const char*)g.A + (size_t)cur.pm * tstep; const char* cB = (const char*)g.Bt + (size_t)cur.pn * tstep;
    S.a_ready(cur);
    if constexpr (SP2) {
        PG8_STAGE(PG8_SB(0, 0), cB, voffB); PG8_STAGE(PG8_SB(0, 1), cB + hstep, voffB); PG8_STAGE(PG8_SA(0, 0), cA, voffA); PG8_STAGE(PG8_SA(0, 1), cA + hstep, voffA);
        if (wr == 1) PG8_BAR;
        PG8_WAIT_V(2); PG8_BAR;
        PG8_STAGE(PG8_SB(1, 0), cB + kstep, voffB); PG8_STAGE(PG8_SA(1, 0), cA + kstep, voffA); PG8_STAGE(PG8_SB(1, 1), cB + hstep + kstep, voffB);
        PG8_WAIT_V(6); PG8_BAR;
    } else {
        PG8_STAGE(PG8_SB(0, 0), cB, voffB); PG8_STAGE(PG8_SA(0, 0), cA, voffA); PG8_STAGE(PG8_SB(0, 1), cB + hstep, voffB); PG8_STAGE(PG8_SA(0, 1), cA + hstep, voffA);
        if (wr == 1) PG8_BAR;
        PG8_WAIT_V(4); PG8_BAR;
        PG8_STAGE(PG8_SB(1, 0), cB + kstep, voffB); PG8_STAGE(PG8_SA(1, 0), cA + kstep, voffA); PG8_STAGE(PG8_SB(1, 1), cB + hstep + kstep, voffB);
        PG8_WAIT_V(6); PG8_BAR;
    }
    for (;;) {
        const bool has_next = S.next(ui + 1, nxt);
        const char* nA = has_next ? (const char*)g.A + (size_t)nxt.pm * tstep : cA; const char* nB = has_next ? (const char*)g.Bt + (size_t)nxt.pn * tstep : cB;
        for (int t = 0; t < nt; t += 2) {
            const bool last = (t == nt - 2);
            const char* a1 = cA + (size_t)(t + 1) * kstep;
            const char* a2 = last ? nA : cA + (size_t)(t + 2) * kstep; const char* b2 = last ? nB : cB + (size_t)(t + 2) * kstep;
            const char* a3 = a2 + kstep; const char* b3 = b2 + kstep;
            if (last && has_next) S.a_ready(nxt);
            if constexpr (SP2) {
            PG8_LDB(B0, 0, 0); PG8_LDB(B1, 0, 1); PG8_SCHED; PG8_LDA(At, 0, 0); PG8_STAGE(PG8_SA(1, 1), a1 + hstep, voffA);
            PG8_WAIT_V(8); PG8_WAIT_L(0); PG8_BAR; PG8_MMA(0, 0, At, B0); PG8_MMA(0, 1, At, B1); PG8_BAR; PG8_SCHED;
            PG8_LDA(At, 0, 1); PG8_STAGE(PG8_SB(0, 0), b2, voffB); PG8_STAGE(PG8_SB(0, 1), b2 + hstep, voffB); PG8_STAGE(PG8_SA(0, 0), a2, voffA);
            PG8_WAIT_V(8); PG8_WAIT_L(0); PG8_BAR; PG8_MMA(1, 0, At, B0); PG8_MMA(1, 1, At, B1); PG8_BAR; PG8_SCHED;
            PG8_LDB(B0, 1, 0); PG8_LDB(B1, 1, 1); PG8_SCHED; PG8_LDA(At, 1, 0); PG8_STAGE(PG8_SA(0, 1), a2 + hstep, voffA);
            PG8_WAIT_V(8); PG8_WAIT_L(0); PG8_BAR; PG8_MMA(0, 0, At, B0); PG8_MMA(0, 1, At, B1); PG8_BAR; PG8_SCHED;
            PG8_LDA(At, 1, 1); PG8_STAGE(PG8_SB(1, 0), b3, voffB); PG8_STAGE(PG8_SB(1, 1), b3 + hstep, voffB); PG8_STAGE(PG8_SA(1, 0), a3, voffA);
            PG8_WAIT_V(8); PG8_WAIT_L(0); PG8_BAR; PG8_MMA(1, 0, At, B0); PG8_MMA(1, 1, At, B1); PG8_BAR; PG8_SCHED;
            } else {
            PG8_LDB(B0, 0, 0); PG8_SCHED; PG8_LDA(At, 0, 0); PG8_STAGE(PG8_SA(1, 1), a1 + hstep, voffA);
            PG8_WAIT_L(8); PG8_BAR; PG8_WAIT_L(0); PG8_MMA(0, 0, At, B0); PG8_BAR; PG8_SCHED;
            PG8_LDB(B1, 0, 1); PG8_STAGE(PG8_SB(0, 0), b2, voffB);
            PG8_BAR; PG8_WAIT_L(0); PG8_MMA(0, 1, At, B1); PG8_BAR;
            PG8_LDA(At, 0, 1); PG8_STAGE(PG8_SA(0, 0), a2, voffA);
            PG8_BAR; PG8_WAIT_L(0); PG8_MMA(1, 0, At, B0); PG8_BAR; PG8_SCHED;
            PG8_STAGE(PG8_SB(0, 1), b2 + hstep, voffB);
            PG8_WAIT_V(6); PG8_BAR; PG8_MMA(1, 1, At, B1); PG8_BAR;
            PG8_LDB(B0, 1, 0); PG8_SCHED; PG8_LDA(At, 1, 0); PG8_STAGE(PG8_SA(0, 1), a2 + hstep, voffA);
            PG8_WAIT_L(8); PG8_BAR; PG8_WAIT_L(0); PG8_MMA(0, 0, At, B0); PG8_BAR; PG8_SCHED;
            PG8_LDB(B1, 1, 1); PG8_STAGE(PG8_SB(1, 0), b3, voffB);
            PG8_BAR; PG8_WAIT_L(0); PG8_MMA(0, 1, At, B1); PG8_BAR;
            PG8_LDA(At, 1, 1); PG8_STAGE(PG8_SA(1, 0), a3, voffA);
            PG8_BAR; PG8_WAIT_L(0); PG8_MMA(1, 0, At, B0); PG8_BAR; PG8_SCHED;
            PG8_STAGE(PG8_SB(1, 1), b3 + hstep, voffB);
            PG8_WAIT_V(6); PG8_BAR; PG8_MMA(1, 1, At, B1); PG8_BAR;
            }
        }
        if constexpr (ALIGN_EPI) { if (wr == 0) PG8_BAR; }
        if constexpr (!Epi::AFTER_DRAIN) { E(acc, cur, wr, wc, fr, fq); S.done(cur); }
        if (!has_next) break;
#pragma unroll
        for (int a = 0; a < 2; ++a)
#pragma unroll
            for (int b = 0; b < 2; ++b)
#pragma unroll
                for (int m = 0; m < 4; ++m)
#pragma unroll
                    for (int n = 0; n < 2; ++n) acc[a][b][m][n] = (f32x4){0.f, 0.f, 0.f, 0.f};
        cur = nxt; cA = nA; cB = nB; ++ui;
        if constexpr (ALIGN_EPI) { if (wr == 1) PG8_BAR; }
    }
    PG8_WAIT_V(0);
    if constexpr (!ALIGN_EPI) { if (wr == 0) PG8_BAR; }
    PG8_BAR;
    if constexpr (Epi::AFTER_DRAIN) { E.fused(acc, cur, wr, wc, fr, fq, lds, wid, lane); S.done(cur); }
#undef PG8_SA
#undef PG8_SB
#undef PG8_STAGE
#undef PG8_LDA
#undef PG8_LDB
#undef PG8_MMA
#undef PG8_WAIT_V
#undef PG8_WAIT_L
#undef PG8_BAR
#undef PG8_SCHED
}
}

#define GAS __attribute__((address_space(1)))
#define LAS __attribute__((address_space(3)))
typedef unsigned short bf16;
typedef unsigned v4u __attribute__((ext_vector_type(4)));
typedef float f32x4 __attribute__((ext_vector_type(4)));
typedef short bf16x8 __attribute__((ext_vector_type(8)));
typedef GAS unsigned gu32;
typedef GAS unsigned long long gu64;
#define RLX_AGENT __ATOMIC_RELAXED, __HIP_MEMORY_SCOPE_AGENT
#define LDS_WAIT() asm volatile("s_waitcnt lgkmcnt(0)" ::: "memory")
#define VM_WAIT() asm volatile("s_waitcnt vmcnt(0)" ::: "memory")
__device__ __forceinline__ unsigned long long rt() { return __builtin_amdgcn_s_memrealtime(); }
__device__ __forceinline__ unsigned f2bf(float f) { unsigned u = __builtin_bit_cast(unsigned, f); return (u + 0x7fffu + ((u >> 16) & 1u)) >> 16; }
__device__ __forceinline__ unsigned pk2(float lo, float hi) { return f2bf(lo) | (f2bf(hi) << 16); }

#define XB_TMO      128
#define XB_XCNT(j)  (256  + 64 * (j))
#define XB_XSUB(j)  (1280 + 64 * (j))
#define XB_XGEN(j)  (2304 + 64 * (j))
#define XB_TOP      3328
#define XB_TOPGEN   3392
#define XCD_BAR_WORDS 3456
#define XB_SPIN_CAP (1u << 18)

__device__ __forceinline__ unsigned xb_ld(unsigned* p)              { return __hip_atomic_load(p, __ATOMIC_RELAXED, __HIP_MEMORY_SCOPE_AGENT); }
__device__ __forceinline__ unsigned xb_add(unsigned* p, unsigned v) { return __hip_atomic_fetch_add(p, v, __ATOMIC_RELAXED, __HIP_MEMORY_SCOPE_AGENT); }
__device__ __forceinline__ unsigned xb_xcc_id() { return (unsigned)__builtin_amdgcn_s_getreg((3 << 11) | 20) & 0xFu; }
#define XB_SPIN(cond, bar) do { unsigned _sp = 0; while (cond) { __builtin_amdgcn_s_sleep(1); \
    if ((++_sp & 255u) == 0u) { if (xb_ld(&(bar)[XB_TMO])) break; if (_sp > XB_SPIN_CAP) { atomicAdd(&(bar)[XB_TMO], 1u); break; } } } } while (0)

struct XcdBarrier {
    unsigned* bar; unsigned x;
    volatile LAS unsigned* st;
};

__device__ __forceinline__ XcdBarrier xcd_barrier_post(unsigned* bar, volatile LAS unsigned* st) {
    XcdBarrier b; b.bar = bar; b.x = xb_xcc_id(); b.st = st;
    if (threadIdx.x == 0) (void)xb_add(&bar[XB_XCNT(b.x)], 1u);
    return b;
}
__device__ __forceinline__ void xcd_barrier_complete(unsigned* bar, unsigned x, unsigned& nloc, unsigned& nx) {
    const unsigned G = gridDim.x * gridDim.y * gridDim.z;
    unsigned sum, cnt, mine, sp = 0u;
    for (;;) {
        sum = 0u; cnt = 0u; mine = 0u;
#pragma unroll
        for (unsigned j = 0; j < 16; ++j) { const unsigned c = xb_ld(&bar[XB_XCNT(j)]); sum += c; cnt += (c > 0u) ? 1u : 0u; mine = (j == x) ? c : mine; }
        if (sum == G) break;
        __builtin_amdgcn_s_sleep(1);
        if ((++sp & 255u) == 0u) { if (xb_ld(&bar[XB_TMO])) break; if (sp > XB_SPIN_CAP) { atomicAdd(&bar[XB_TMO], 1u); break; } }
    }
    nloc = mine > 0u ? mine : 1u; nx = cnt > 0u ? cnt : 1u;
}

__device__ __forceinline__ void xcd_barrier(const XcdBarrier& b) {
    asm volatile("s_waitcnt vmcnt(0)" ::: "memory");
    __syncthreads();
    if (threadIdx.x == 0) {
        unsigned* bar = b.bar;
        __builtin_amdgcn_s_waitcnt(0);
        unsigned nloc = b.st[0], nx = b.st[1];
        if (nloc == 0u) { xcd_barrier_complete(bar, b.x, nloc, nx); b.st[0] = nloc; b.st[1] = nx; }
        const unsigned old = xb_add(&bar[XB_XSUB(b.x)], 1u);
        const unsigned gen = old / nloc;
        if (old + 1u == (gen + 1u) * nloc) {
            __builtin_amdgcn_fence(__ATOMIC_RELEASE, "agent");
            asm volatile("s_waitcnt vmcnt(0)" ::: "memory");
            const unsigned og = xb_add(&bar[XB_TOP], 1u);
            const unsigned tg = og / nx;
            if (og + 1u == (tg + 1u) * nx) xb_add(&bar[XB_TOPGEN], 1u);
            else XB_SPIN(xb_ld(&bar[XB_TOPGEN]) == tg, bar);
            __builtin_amdgcn_fence(__ATOMIC_ACQUIRE, "agent");
            xb_add(&bar[XB_XGEN(b.x)], 1u);
            asm volatile("s_waitcnt vmcnt(0)" ::: "memory");
        } else {
            XB_SPIN(xb_ld(&bar[XB_XGEN(b.x)]) == gen, bar);
            __builtin_amdgcn_fence(__ATOMIC_ACQUIRE, "agent");
            asm volatile("s_waitcnt vmcnt(0)" ::: "memory");
        }
    }
    __syncthreads();
}

constexpr int NWAVES = 8;
constexpr int BATCH = 16, SEQ = 4096, DM = 1024, M = BATCH * SEQ;
constexpr int NPROJ = 2592, NPAD = 2816;
constexpr int C_Q = 0, C_K = 256, C_V = 512, C_ZG = 1024, C_U = 1536, C_ZF = 2048, C_GF = 2560, C_GB = 2576;
constexpr float LN_EPS = 1e-5f, RMS_EPS = 1e-6f;
constexpr float DN_ALPHA = 1.189207115002721f;
constexpr float FN_SCALE = 0.0013810679320049757f;

constexpr size_t MiB = 1u << 20;
constexpr size_t WS_CTL = 0, CTL_ZERO_BYTES = 1 * MiB;
constexpr size_t WS_WIN = 2 * MiB;
constexpr size_t WS_WOUT = 8 * MiB;
constexpr size_t WS_CW = 10 * MiB;
constexpr size_t WS_XB = 16 * MiB;
constexpr size_t WS_PR = 144 * MiB;
constexpr size_t WS_MIX = 496 * MiB;
constexpr size_t WS_AP = 624 * MiB, WS_BP = 688 * MiB;
constexpr size_t WS_YR = 752 * MiB, WS_YI = 816 * MiB;
constexpr size_t WS_OF = 880 * MiB, WS_OB = 944 * MiB;
constexpr size_t WS_END = 1008 * MiB;
constexpr int CW_TMO = 0, CW_CODE = 1, CW_BAR = 4096;

constexpr int RING_BYTES = 131072, LDSCTL_OFF = RING_BYTES, MISC_OFF = LDSCTL_OFF + 320, LDS_BYTES = 147456;

__device__ __forceinline__ float bf2f(unsigned short h) { return __uint_as_float((unsigned)h << 16); }
__device__ __forceinline__ float wave_sum(float v) {
#pragma unroll
    for (int o = 1; o < 64; o <<= 1) v += __shfl_xor(v, o);
    return v;
}
__device__ __forceinline__ float silu_f(float z) { return z / (1.f + __expf(-z)); }

struct Frame {
    LAS unsigned char* lds;
    volatile LAS unsigned* MISC;
    gu32* ctl;
    int tid, lane, wave, G;
    const float *x, *w_in, *wgu_f, *bg_f, *wgu_b, *bg_b, *gng, *w_fnet, *w_out, *ln_g, *ln_b;
    float* out;
    bf16 *WIN, *WOUT, *XB, *PR, *MIX, *AP, *BP, *YR, *YI, *OF, *OB;
    float *CW, *SW, *TWC, *TWS;
};

__device__ __forceinline__ void p0_transpose_item(const float* W, int K, int N, bf16* WT, int k0, int n0, int drow0, float sc, LAS float* scr, int lane) {
#pragma unroll 8
    for (int i = 0; i < 32; ++i) { const int kk = 2 * i + (lane >> 5); scr[kk * 33 + (lane & 31)] = W[(size_t)(k0 + kk) * N + n0 + (lane & 31)] * sc; }
    LDS_WAIT(); asm volatile("" ::: "memory");
    const int c = lane & 7;
#pragma unroll
    for (int j = 0; j < 4; ++j) { const int n = (lane >> 3) + 8 * j; const LAS float* s = scr + (8 * c) * 33 + n;
        v4u o; o.x = pk2(s[0 * 33], s[1 * 33]); o.y = pk2(s[2 * 33], s[3 * 33]); o.z = pk2(s[4 * 33], s[5 * 33]); o.w = pk2(s[6 * 33], s[7 * 33]);
        *(GAS v4u*)(WT + (size_t)(drow0 + n) * K + k0 + 8 * c) = o; }
    LDS_WAIT(); asm volatile("" ::: "memory");
}

__device__ __forceinline__ void ph_prep(Frame& F) {
    LAS float* scr = (LAS float*)(F.lds + F.wave * 16384);
    const int gw = blockIdx.x * NWAVES + F.wave, NGW = F.G * NWAVES;
    constexpr int NB_IN = NPROJ / 32, I_IN = (DM / 64) * NB_IN, I_OUT = (DM / 64) * (DM / 32);
    for (int it = gw; it < I_IN + I_OUT; it += NGW) {
        if (it < I_IN) {
            const int kb = it / NB_IN, nb = it % NB_IN, n0 = nb * 32;
            const int drow0 = (n0 < 1024) ? n0 : (n0 == 1024 ? C_GF : n0 - 32);
            p0_transpose_item(F.w_in, DM, NPROJ, F.WIN, kb * 64, n0, drow0, (n0 < 256) ? 0.125f : 1.f, scr, F.lane);
        } else {
            const int r = it - I_IN, kb = r / (DM / 32), nb = r % (DM / 32);
            p0_transpose_item(F.w_out, DM, DM, F.WOUT, kb * 64, nb * 32, nb * 32, 1.f, scr, F.lane);
        }
    }
    const int gt = blockIdx.x * (NWAVES * 64) + F.tid, NGT = F.G * NWAVES * 64;
    for (int i = gt; i < (NPAD - NPROJ) * DM / 8; i += NGT) ((GAS v4u*)(F.WIN + (size_t)NPROJ * DM))[i] = (v4u){0u, 0u, 0u, 0u};
    for (size_t i = gt; i < (size_t)M * DM / 8; i += NGT) {
        const f32x4 a = ((const GAS f32x4*)F.x)[2 * i], b = ((const GAS f32x4*)F.x)[2 * i + 1];
        v4u o; o.x = pk2(a.x, a.y); o.y = pk2(a.z, a.w); o.z = pk2(b.x, b.y); o.w = pk2(b.z, b.w);
        ((GAS v4u*)F.XB)[i] = o;
    }
    for (int i = gt; i < 4 * 128 * 128; i += NGT) {
        const int d = i & 127, c = (i >> 7) & 127, g = i >> 14;
        float sc_ = 0.f, ss_ = 0.f;
        for (int k = 0; k < 128; ++k) { float sn, cs; sincospif((float)((c * k) & 127) * (1.f / 64.f), &sn, &cs); const float w = F.w_fnet[(g * 128 + k) * 128 + d]; sc_ += cs * w; ss_ += sn * w; }
        F.CW[i] = sc_; F.SW[i] = ss_;
    }
    for (int i = gt; i < 4096; i += NGT) { float sn, cs; sincospif((float)((i >> 6) * (i & 63)) * (1.f / 2048.f), &sn, &cs); F.TWC[i] = cs; F.TWS[i] = sn; }
}

namespace gla {
constexpr int RS = 144;
constexpr int TILE = 64 * RS;
constexpr int O_QT = 0, O_KT = TILE, O_KD = 2 * TILE, O_V = 3 * TILE, O_P = 4 * TILE, O_ST = 5 * TILE, O_LH = 6 * TILE, O_LL = 7 * TILE;
constexpr int O_BF = 8 * TILE, BRS = 272;
constexpr int O_END = O_BF + 64 * BRS;
typedef short v4i16_t __attribute__((ext_vector_type(4)));
typedef unsigned u32x2 __attribute__((ext_vector_type(2)));
__device__ __forceinline__ bf16x8 ldfrag(const LAS unsigned char* p) { return *(const LAS bf16x8*)p; }
__device__ __forceinline__ bf16x8 trfrag(const LAS unsigned char* p) {
    const v4i16_t a = __builtin_amdgcn_ds_read_tr16_b64_v4i16((LAS v4i16_t*)p);
    const v4i16_t b = __builtin_amdgcn_ds_read_tr16_b64_v4i16((LAS v4i16_t*)(p + 4 * RS));
    return (bf16x8){a.x, a.y, a.z, a.w, b.x, b.y, b.z, b.w};
}
__device__ __forceinline__ f32x4 mma(bf16x8 a, bf16x8 b, f32x4 c) { return __builtin_amdgcn_mfma_f32_16x16x32_bf16(a, b, c, 0, 0, 0); }
}

__device__ __forceinline__ void ph_gla(Frame& F) {
    using namespace gla;
    LAS unsigned char* L = F.lds;
    const int tid = F.tid, lane = F.lane, w = F.wave;
    const int c = lane & 15, g = lane >> 4, q4 = (lane & 15) >> 2, p4 = lane & 3;
    const int mrow = w >> 1, nb = 2 * (w & 1);
    const int ri = tid >> 3, seg = tid & 7;
    const f32x4 zero4 = {0.f, 0.f, 0.f, 0.f};
    bf16x8 lfr[2];
#pragma unroll
    for (int ks = 0; ks < 2; ++ks)
#pragma unroll
        for (int e = 0; e < 8; ++e) lfr[ks][e] = (32 * ks + 8 * g + e <= 16 * mrow + c) ? (short)0x3F80 : (short)0;
    for (int it = blockIdx.x; it < BATCH * 4 * 2 * 2; it += F.G) {
        const int vs = it & 1, dir = (it >> 1) & 1, h = (it >> 2) & 3, b = it >> 4;
        const float* wg = dir ? F.wgu_b : F.wgu_f; const float* bg = dir ? F.bg_b : F.bg_f;
        bf16* O = dir ? F.OB : F.OF;
        bf16x8 wub[2]; float bias2[2];
#pragma unroll
        for (int t = 0; t < 2; ++t) { const int col = 64 * h + 16 * (nb + t) + c; bias2[t] = bg[col];
#pragma unroll
            for (int e = 0; e < 8; ++e) wub[t][e] = (g < 2) ? (short)f2bf(wg[(8 * g + e) * 256 + col]) : (short)0; }
        __syncthreads();
        for (int i = tid; i < TILE / 4; i += NWAVES * 64) ((LAS unsigned*)(L + O_ST))[i] = 0u;
        f32x4 Sacc[2] = {zero4, zero4};
        v4u cq, ck, cv, cg;
        { const int tok = dir ? (SEQ - 1 - ri) : ri; const bf16* rp = F.PR + (size_t)(b * SEQ + tok) * NPAD;
          cq = *(const GAS v4u*)(rp + C_Q + 64 * h + 8 * seg); ck = *(const GAS v4u*)(rp + C_K + 64 * h + 8 * seg); cv = *(const GAS v4u*)(rp + C_V + 128 * h + 64 * vs + 8 * seg);
          const int r2 = 16 * mrow + c, tok2 = dir ? (SEQ - 1 - r2) : r2;
          cg = (v4u){0u, 0u, 0u, 0u}; if (g < 2) cg = *(const GAS v4u*)(F.PR + (size_t)(b * SEQ + tok2) * NPAD + C_GF + 16 * dir + 8 * g); }
        for (int blk = 0; blk < 64; ++blk) {
            v4u nq = cq, nk = ck, nv = cv, ng = cg;
            if (blk + 1 < 64) { const int r1 = (blk + 1) * 64 + ri, tok = dir ? (SEQ - 1 - r1) : r1; const bf16* rp = F.PR + (size_t)(b * SEQ + tok) * NPAD;
                nq = *(const GAS v4u*)(rp + C_Q + 64 * h + 8 * seg); nk = *(const GAS v4u*)(rp + C_K + 64 * h + 8 * seg); nv = *(const GAS v4u*)(rp + C_V + 128 * h + 64 * vs + 8 * seg);
                const int r2 = (blk + 1) * 64 + 16 * mrow + c, tok2 = dir ? (SEQ - 1 - r2) : r2;
                ng = (v4u){0u, 0u, 0u, 0u}; if (g < 2) ng = *(const GAS v4u*)(F.PR + (size_t)(b * SEQ + tok2) * NPAD + C_GF + 16 * dir + 8 * g); }
            { const bf16x8 ga = __builtin_bit_cast(bf16x8, cg);
#pragma unroll
              for (int t = 0; t < 2; ++t) { const f32x4 pre = mma(ga, wub[t], zero4); unsigned hh[4], ll[4];
#pragma unroll
                  for (int r = 0; r < 4; ++r) { const float x = pre[r] + bias2[t]; const float la = (fminf(x, 0.f) - __logf(1.f + __expf(-fabsf(x)))) * (1.f / 16.f);
                      hh[r] = f2bf(la); ll[r] = f2bf(la - __uint_as_float(hh[r] << 16)); }
                  const int off = (16 * (nb + t) + c) * RS + (16 * mrow + 4 * g) * 2;
                  *(LAS u32x2*)(L + O_LH + off) = (u32x2){hh[0] | (hh[1] << 16), hh[2] | (hh[3] << 16)};
                  *(LAS u32x2*)(L + O_LL + off) = (u32x2){ll[0] | (ll[1] << 16), ll[2] | (ll[3] << 16)}; } }
            __syncthreads();
#pragma unroll
            for (int t = 0; t < 2; ++t) { const int md = nb + t; f32x4 acc = zero4;
                const LAS unsigned char* ah = L + O_LH + (16 * md + c) * RS + 16 * g; const LAS unsigned char* al = L + O_LL + (16 * md + c) * RS + 16 * g;
                acc = mma(ldfrag(ah), lfr[0], acc); acc = mma(ldfrag(al), lfr[0], acc);
                if (mrow >= 2) { acc = mma(ldfrag(ah + 64), lfr[1], acc); acc = mma(ldfrag(al + 64), lfr[1], acc); }
                *(LAS f32x4*)(L + O_BF + (16 * mrow + c) * BRS + (16 * md + 4 * g) * 4) = acc; }
            __syncthreads();
            { const f32x4 b0 = *(const LAS f32x4*)(L + O_BF + ri * BRS + seg * 32), b1 = *(const LAS f32x4*)(L + O_BF + ri * BRS + seg * 32 + 16);
              const f32x4 l0 = *(const LAS f32x4*)(L + O_BF + 63 * BRS + seg * 32), l1 = *(const LAS f32x4*)(L + O_BF + 63 * BRS + seg * 32 + 16);
              float bb[8] = {b0[0], b0[1], b0[2], b0[3], b1[0], b1[1], b1[2], b1[3]}; float bl[8] = {l0[0], l0[1], l0[2], l0[3], l1[0], l1[1], l1[2], l1[3]};
              const unsigned qw[4] = {cq.x, cq.y, cq.z, cq.w}, kw[4] = {ck.x, ck.y, ck.z, ck.w};
              unsigned oq[4], ok[4], od[4];
#pragma unroll
              for (int e = 0; e < 4; ++e) {
                  const float q0 = __uint_as_float(qw[e] << 16), q1 = __uint_as_float(qw[e] & 0xffff0000u), k0 = __uint_as_float(kw[e] << 16), k1 = __uint_as_float(kw[e] & 0xffff0000u);
                  const float x0 = bb[2 * e], x1 = bb[2 * e + 1];
                  oq[e] = pk2(q0 * __expf(x0), q1 * __expf(x1)); ok[e] = pk2(k0 * __expf(-x0), k1 * __expf(-x1));
                  od[e] = pk2(k0 * __expf(bl[2 * e] - x0), k1 * __expf(bl[2 * e + 1] - x1)); }
              *(LAS v4u*)(L + O_QT + ri * RS + seg * 16) = (v4u){oq[0], oq[1], oq[2], oq[3]};
              *(LAS v4u*)(L + O_KT + ri * RS + seg * 16) = (v4u){ok[0], ok[1], ok[2], ok[3]};
              *(LAS v4u*)(L + O_KD + ri * RS + seg * 16) = (v4u){od[0], od[1], od[2], od[3]};
              *(LAS v4u*)(L + O_V + ri * RS + seg * 16) = cv; }
            __syncthreads();
            f32x4 oacc[2];
            { const bf16x8 qb0 = ldfrag(L + O_QT + (16 * mrow + c) * RS + 16 * g), qb1 = ldfrag(L + O_QT + (16 * mrow + c) * RS + 64 + 16 * g);
#pragma unroll
              for (int t = 0; t < 2; ++t) { const int mj = nb + t; f32x4 pt = zero4;
                  if (mj <= mrow) { const LAS unsigned char* ka = L + O_KT + (16 * mj + c) * RS + 16 * g; pt = mma(ldfrag(ka), qb0, pt); pt = mma(ldfrag(ka + 64), qb1, pt); }
                  float pm[4];
#pragma unroll
                  for (int r = 0; r < 4; ++r) pm[r] = (16 * mj + 4 * g + r <= 16 * mrow + c) ? pt[r] : 0.f;
                  *(LAS u32x2*)(L + O_P + (16 * mrow + c) * RS + (16 * mj + 4 * g) * 2) = (u32x2){pk2(pm[0], pm[1]), pk2(pm[2], pm[3])};
                  const LAS unsigned char* sa = L + O_ST + (16 * mj + c) * RS + 16 * g;
                  oacc[t] = mma(ldfrag(sa), qb0, zero4); oacc[t] = mma(ldfrag(sa + 64), qb1, oacc[t]); } }
            __syncthreads();
            { const bf16x8 pb0 = ldfrag(L + O_P + (16 * mrow + c) * RS + 16 * g);
              bf16x8 pb1 = pb0; if (mrow >= 2) pb1 = ldfrag(L + O_P + (16 * mrow + c) * RS + 64 + 16 * g);
              const int r2 = blk * 64 + 16 * mrow + c, tok = dir ? (SEQ - 1 - r2) : r2;
              bf16* orow = O + (size_t)(b * SEQ + tok) * 512 + 128 * h + 64 * vs;
#pragma unroll
              for (int t = 0; t < 2; ++t) { const int mv = nb + t; const LAS unsigned char* va = L + O_V + (8 * g + q4) * RS + (16 * mv + 4 * p4) * 2;
                  oacc[t] = mma(trfrag(va), pb0, oacc[t]);
                  if (mrow >= 2) oacc[t] = mma(trfrag(va + 32 * RS), pb1, oacc[t]);
                  *(GAS u32x2*)(orow + 16 * mv + 4 * g) = (u32x2){pk2(oacc[t][0], oacc[t][1]), pk2(oacc[t][2], oacc[t][3])}; }
              const f32x4 blv = *(const LAS f32x4*)(L + O_BF + 63 * BRS + (16 * mrow + 4 * g) * 4);
              const f32x4 dec = {__expf(blv[0]), __expf(blv[1]), __expf(blv[2]), __expf(blv[3])};
              const LAS unsigned char* kda = L + O_KD + (8 * g + q4) * RS + (16 * mrow + 4 * p4) * 2;
              const bf16x8 ka0 = trfrag(kda), ka1 = trfrag(kda + 32 * RS);
#pragma unroll
              for (int t = 0; t < 2; ++t) { const int nv_ = nb + t; const LAS unsigned char* vb = L + O_V + (8 * g + q4) * RS + (16 * nv_ + 4 * p4) * 2;
                  f32x4 s = Sacc[t] * dec; s = mma(ka0, trfrag(vb), s); s = mma(ka1, trfrag(vb + 32 * RS), s); Sacc[t] = s;
                  *(LAS u32x2*)(L + O_ST + (16 * nv_ + c) * RS + (16 * mrow + 4 * g) * 2) = (u32x2){pk2(s[0], s[1]), pk2(s[2], s[3])}; } }
            cq = nq; ck = nk; cv = nv; cg = ng;
        }
    }
}


namespace fn {
constexpr int URS = 272;
constexpr int O_U = 0, O_MR = 128 * URS, O_MI = O_MR + 64 * URS, F1_END = O_MI + 64 * URS;
constexpr int YRS = 528;
constexpr int O_Y2R = 0, O_Y2I = 64 * YRS, O_MX = 2 * 64 * YRS, F2_END = O_MX + 64 * URS;
template <int STRIDE> __device__ __forceinline__ bf16x8 trfrag_s(const LAS unsigned char* p) {
    const gla::v4i16_t a = __builtin_amdgcn_ds_read_tr16_b64_v4i16((LAS gla::v4i16_t*)p);
    const gla::v4i16_t b = __builtin_amdgcn_ds_read_tr16_b64_v4i16((LAS gla::v4i16_t*)(p + 4 * STRIDE));
    return (bf16x8){a.x, a.y, a.z, a.w, b.x, b.y, b.z, b.w};
}
__device__ __forceinline__ int kperm(int pos) { const int ks = pos >> 5, gg = (pos >> 3) & 3, jj = pos & 7; return 32 * ks + (jj < 4 ? 4 * gg + jj : 16 + 4 * gg + (jj - 4)); }
}

__device__ __forceinline__ void ph_f1(Frame& F) {
    using namespace fn; using gla::mma; using gla::ldfrag; using gla::u32x2;
    LAS unsigned char* L = F.lds;
    const int tid = F.tid, lane = F.lane, w = F.wave, c = lane & 15, g4 = lane >> 4;
    const f32x4 zero4 = {0.f, 0.f, 0.f, 0.f};
    for (int idx = tid; idx < 64 * 128; idx += NWAVES * 64) { const int k1 = idx >> 7, pos = idx & 127, K = kperm(pos), n1 = K & 63;
        float s, cs; sincospif((float)((k1 * n1) & 63) * (1.f / 32.f), &s, &cs);
        const float mr = (K < 64) ? cs : -s, mi = (K < 64) ? -s : -cs;
        *(LAS bf16*)(L + O_MR + k1 * URS + pos * 2) = (bf16)f2bf(mr); *(LAS bf16*)(L + O_MI + k1 * URS + pos * 2) = (bf16)f2bf(mi); }
    int cur_g = -1; bf16x8 wfr[2][4];
    const int lrow = tid >> 2, lq = tid & 3;
    v4u pu[4];
    int it = blockIdx.x;
    if (it < BATCH * 4 * 32) { const int g = it & 3, e0 = (it >> 2) & 31, b = it >> 7; const bf16* src = F.PR + (size_t)(b * SEQ + 64 * (lrow & 63) + 2 * e0 + (lrow >> 6)) * NPAD + C_U + 128 * g + 32 * lq;
#pragma unroll
        for (int j = 0; j < 4; ++j) pu[j] = *(const GAS v4u*)(src + 8 * j); }
    for (; it < BATCH * 4 * 32; it += F.G) {
        const int g = it & 3, e0 = (it >> 2) & 31, b = it >> 7;
        if (g != cur_g) { cur_g = g;
#pragma unroll
            for (int ab = 0; ab < 2; ++ab) { const float* Wm = (ab ? F.SW : F.CW) + g * 16384 + 16 * w + c;
#pragma unroll
                for (int ks = 0; ks < 4; ++ks)
#pragma unroll
                    for (int e = 0; e < 8; ++e) wfr[ab][ks][e] = (short)f2bf(Wm[(32 * ks + 8 * g4 + e) * 128]); } }
        __syncthreads();
#pragma unroll
        for (int j = 0; j < 4; ++j) *(LAS v4u*)(L + O_U + lrow * URS + lq * 64 + j * 16) = pu[j];
        __syncthreads();
        { const int nit = it + F.G; if (nit < BATCH * 4 * 32) { const int g2 = nit & 3, e2 = (nit >> 2) & 31, b2 = nit >> 7; const bf16* src = F.PR + (size_t)(b2 * SEQ + 64 * (lrow & 63) + 2 * e2 + (lrow >> 6)) * NPAD + C_U + 128 * g2 + 32 * lq;
#pragma unroll
            for (int j = 0; j < 4; ++j) pu[j] = *(const GAS v4u*)(src + 8 * j); } }
#pragma unroll 1
        for (int e = 0; e < 2; ++e) {
            f32x4 a1[4][2];
#pragma unroll
            for (int mt = 0; mt < 4; ++mt) { a1[mt][0] = zero4; a1[mt][1] = zero4;
#pragma unroll
                for (int ks = 0; ks < 4; ++ks) { const bf16x8 uf = ldfrag(L + O_U + (64 * e + 16 * mt + c) * URS + (32 * ks + 8 * g4) * 2);
                    a1[mt][0] = mma(uf, wfr[0][ks], a1[mt][0]); a1[mt][1] = mma(uf, wfr[1][ks], a1[mt][1]); } }
            bf16x8 xf[4];
#pragma unroll
            for (int ks = 0; ks < 4; ++ks) { const int ab = ks >> 1, t0 = 2 * (ks & 1); const f32x4 x0 = a1[t0][ab], x1 = a1[t0 + 1][ab];
                const v4u pk = {pk2(x0[0], x0[1]), pk2(x0[2], x0[3]), pk2(x1[0], x1[1]), pk2(x1[2], x1[3])}; xf[ks] = __builtin_bit_cast(bf16x8, pk); }
            const int n2 = 2 * e0 + e;
#pragma unroll 1
            for (int m = 0; m < 4; ++m) { f32x4 ar = zero4, ai = zero4;
#pragma unroll
                for (int ks = 0; ks < 4; ++ks) { const bf16x8 mr = ldfrag(L + O_MR + (16 * m + c) * URS + (32 * ks + 8 * g4) * 2), mi = ldfrag(L + O_MI + (16 * m + c) * URS + (32 * ks + 8 * g4) * 2);
                    ar = mma(xf[ks], mr, ar); ai = mma(xf[ks], mi, ai); }
                const int k1 = 16 * m + c;
                const float tc = F.TWC[n2 * 64 + k1], ts = F.TWS[n2 * 64 + k1];
                float pr[4], pi[4];
#pragma unroll
                for (int r = 0; r < 4; ++r) { pr[r] = ar[r] * tc + ai[r] * ts; pi[r] = ai[r] * tc - ar[r] * ts; }
                const size_t o = (size_t)(b * SEQ + k1 * 64 + n2) * 512 + 128 * g + 16 * w + 4 * g4;
                *(GAS u32x2*)(F.YR + o) = (u32x2){pk2(pr[0], pr[1]), pk2(pr[2], pr[3])}; *(GAS u32x2*)(F.YI + o) = (u32x2){pk2(pi[0], pi[1]), pk2(pi[2], pi[3])}; }
        }
    }
}

__device__ __forceinline__ void ph_f2(Frame& F) {
    using namespace fn; using gla::mma; using gla::ldfrag; using gla::u32x2;
    LAS unsigned char* L = F.lds;
    const int tid = F.tid, lane = F.lane, w = F.wave, c = lane & 15, g4 = lane >> 4, q4 = (lane & 15) >> 2, p4 = lane & 3;
    const f32x4 zero4 = {0.f, 0.f, 0.f, 0.f};
    for (int idx = tid; idx < 64 * 128; idx += NWAVES * 64) { const int k2 = idx >> 7, K = idx & 127, n2 = K & 63;
        float s, cs; sincospif((float)((k2 * n2) & 63) * (1.f / 32.f), &s, &cs);
        *(LAS bf16*)(L + O_MX + k2 * URS + K * 2) = (bf16)f2bf(K < 64 ? cs : s); }
    const int lrow = tid >> 3, lp = tid & 7;
    v4u py[2][4];
    int it = blockIdx.x;
    if (it < BATCH * 64 * 2) { const int hf = it & 1, k1 = (it >> 1) & 63, b = it >> 7; const size_t so = (size_t)(b * SEQ + k1 * 64 + lrow) * 512 + 256 * hf + 32 * lp;
#pragma unroll
        for (int j = 0; j < 4; ++j) { py[0][j] = *(const GAS v4u*)(F.YR + so + 8 * j); py[1][j] = *(const GAS v4u*)(F.YI + so + 8 * j); } }
    for (; it < BATCH * 64 * 2; it += F.G) {
        const int hf = it & 1, k1 = (it >> 1) & 63, b = it >> 7;
        __syncthreads();
#pragma unroll
        for (int j = 0; j < 4; ++j) { *(LAS v4u*)(L + O_Y2R + lrow * YRS + lp * 64 + j * 16) = py[0][j]; *(LAS v4u*)(L + O_Y2I + lrow * YRS + lp * 64 + j * 16) = py[1][j]; }
        __syncthreads();
        { const int nit = it + F.G; if (nit < BATCH * 64 * 2) { const int hf2 = nit & 1, k12 = (nit >> 1) & 63, b2 = nit >> 7; const size_t so = (size_t)(b2 * SEQ + k12 * 64 + lrow) * 512 + 256 * hf2 + 32 * lp;
#pragma unroll
            for (int j = 0; j < 4; ++j) { py[0][j] = *(const GAS v4u*)(F.YR + so + 8 * j); py[1][j] = *(const GAS v4u*)(F.YI + so + 8 * j); } } }
        f32x4 acc[2][4];
#pragma unroll
        for (int ct = 0; ct < 2; ++ct)
#pragma unroll
            for (int nt = 0; nt < 4; ++nt) acc[ct][nt] = zero4;
#pragma unroll
        for (int ks = 0; ks < 4; ++ks) { const LAS unsigned char* img = L + ((ks < 2) ? O_Y2R : O_Y2I) + (32 * (ks & 1) + 8 * g4 + q4) * YRS + (32 * w + 4 * p4) * 2;
            const bf16x8 a0 = trfrag_s<YRS>(img), a1 = trfrag_s<YRS>(img + 32);
#pragma unroll
            for (int nt = 0; nt < 4; ++nt) { const bf16x8 bm = ldfrag(L + O_MX + (16 * nt + c) * URS + (32 * ks + 8 * g4) * 2);
                acc[0][nt] = mma(a0, bm, acc[0][nt]); acc[1][nt] = mma(a1, bm, acc[1][nt]); } }
#pragma unroll
        for (int nt = 0; nt < 4; ++nt) { const size_t row = (size_t)(b * SEQ + k1 + 64 * (16 * nt + c));
#pragma unroll
            for (int ct = 0; ct < 2; ++ct) { const int col = 256 * hf + 32 * w + 16 * ct + 4 * g4;
                const u32x2 zz = *(const GAS u32x2*)(F.PR + row * NPAD + C_ZF + col);
                const float z0 = __uint_as_float(zz.x << 16), z1 = __uint_as_float(zz.x & 0xffff0000u), z2 = __uint_as_float(zz.y << 16), z3 = __uint_as_float(zz.y & 0xffff0000u);
                const f32x4 x = acc[ct][nt] * FN_SCALE;
                *(GAS u32x2*)(F.MIX + row * DM + 512 + col) = (u32x2){pk2(x[0] * silu_f(z0), x[1] * silu_f(z1)), pk2(x[2] * silu_f(z2), x[3] * silu_f(z3))}; } }
    }
}

__device__ __forceinline__ void ph_mixbuild(Frame& F) {
    const int gw = blockIdx.x * NWAVES + F.wave, NGW = F.G * NWAVES, lane = F.lane;
    for (int it = gw; it < M * 4; it += NGW) {
        const int h = it & 3; const size_t row = (size_t)(it >> 2);
        const unsigned a = *(const GAS unsigned*)(F.OF + row * 512 + h * 128 + 2 * lane), b = *(const GAS unsigned*)(F.OB + row * 512 + h * 128 + 2 * lane);
        const unsigned zz = *(const GAS unsigned*)(F.PR + row * NPAD + C_ZG + h * 128 + 2 * lane);
        const float o0 = __uint_as_float(a << 16) + __uint_as_float(b << 16), o1 = __uint_as_float(a & 0xffff0000u) + __uint_as_float(b & 0xffff0000u);
        const float ss = wave_sum(o0 * o0 + o1 * o1);
        const float rstd = 1.0f / sqrtf(ss * (1.f / 128.f) + RMS_EPS);
        const float g0 = F.gng[h * 128 + 2 * lane], g1 = F.gng[h * 128 + 2 * lane + 1];
        const float m0 = o0 * rstd * g0 * silu_f(__uint_as_float(zz << 16)), m1 = o1 * rstd * g1 * silu_f(__uint_as_float(zz & 0xffff0000u));
        *(GAS unsigned*)(F.MIX + row * DM + h * 128 + 2 * lane) = pk2(m0, m1);
    }
}

__device__ __forceinline__ void ph_ln(Frame& F, bool bad) {
    const int gw = blockIdx.x * NWAVES + F.wave, NGW = F.G * NWAVES;
    const float qnan = __builtin_nanf("");
    for (int m = gw; m < M; m += NGW) {
        GAS f32x4* xr = (GAS f32x4*)(F.out + (size_t)m * DM) + F.lane;
        f32x4 v[4]; float s = 0.f;
#pragma unroll
        for (int j = 0; j < 4; ++j) { v[j] = xr[64 * j]; s += (v[j].x + v[j].y) + (v[j].z + v[j].w); }
        const float mean = wave_sum(s) * (1.f / DM); float s2 = 0.f;
#pragma unroll
        for (int j = 0; j < 4; ++j) { v[j] = v[j] - mean; s2 += (v[j].x * v[j].x + v[j].y * v[j].y) + (v[j].z * v[j].z + v[j].w * v[j].w); }
        const float rstd = 1.f / sqrtf(wave_sum(s2) * (1.f / DM) + LN_EPS);
#pragma unroll
        for (int j = 0; j < 4; ++j) { const f32x4 g = ((const GAS f32x4*)F.ln_g)[F.lane + 64 * j], bb = ((const GAS f32x4*)F.ln_b)[F.lane + 64 * j];
            f32x4 o = v[j] * rstd * g + bb; if (bad) o = (f32x4){qnan, qnan, qnan, qnan}; xr[64 * j] = o; }
    }
}

constexpr int N_PHASES = 6;
#ifndef MK_N_LAUNCHES
#define MK_N_LAUNCHES 1
#endif
struct Args { const float* in[11]; float* out; unsigned char* ws; int ph_lo, ph_hi, li, pad; };
__global__ void __launch_bounds__(NWAVES * 64, 2) fwd_kernel(Args args) {
    extern __shared__ __attribute__((aligned(16))) unsigned char lds[];
    Frame F;
    F.lds = (LAS unsigned char*)lds;
    F.MISC = (volatile LAS unsigned*)(F.lds + MISC_OFF);
    F.tid = threadIdx.x; F.lane = F.tid & 63; F.wave = __builtin_amdgcn_readfirstlane(F.tid >> 6); F.G = gridDim.x;
    unsigned char* ws = args.ws;
    F.ctl = (gu32*)(ws + WS_CTL);
    F.x = args.in[0]; F.w_in = args.in[1]; F.wgu_f = args.in[2]; F.bg_f = args.in[3]; F.wgu_b = args.in[4]; F.bg_b = args.in[5];
    F.gng = args.in[6]; F.w_fnet = args.in[7]; F.w_out = args.in[8]; F.ln_g = args.in[9]; F.ln_b = args.in[10]; F.out = args.out;
    F.WIN = (bf16*)(ws + WS_WIN); F.WOUT = (bf16*)(ws + WS_WOUT); F.XB = (bf16*)(ws + WS_XB); F.PR = (bf16*)(ws + WS_PR); F.MIX = (bf16*)(ws + WS_MIX);
    F.AP = (bf16*)(ws + WS_AP); F.BP = (bf16*)(ws + WS_BP); F.YR = (bf16*)(ws + WS_YR); F.YI = (bf16*)(ws + WS_YI); F.OF = (bf16*)(ws + WS_OF); F.OB = (bf16*)(ws + WS_OB);
    F.CW = (float*)(ws + WS_CW); F.SW = F.CW + 4 * 128 * 128; F.TWC = F.SW + 4 * 128 * 128; F.TWS = F.TWC + 4096;
    for (int u = F.tid; u < (LDS_BYTES - LDSCTL_OFF) / 4; u += NWAVES * 64) ((LAS unsigned*)(F.lds + LDSCTL_OFF))[u] = 0u;
    __syncthreads();
    const int lo = args.ph_lo, hi = args.ph_hi;
    const bool use_bar = (hi - lo) > 1;
    XcdBarrier bar; bar.bar = (unsigned*)(F.ctl + CW_BAR) + args.li * XCD_BAR_WORDS; bar.x = 0; bar.st = nullptr;
    if (use_bar) bar = xcd_barrier_post((unsigned*)(F.ctl + CW_BAR) + args.li * XCD_BAR_WORDS, F.MISC + 8);
#define IN(k) (lo <= (k) && (k) < hi)
#define SEAM(k) do { if (IN(k) && IN((k) + 1)) xcd_barrier(bar); } while (0)
    if (IN(0)) { ph_prep(F); SEAM(0); }
    if (IN(1)) {
        pg8::Gemm g{F.XB, F.WIN, M, NPAD, DM}; pg8::StaticOrder S; S.init(M, NPAD, F.G, (int)blockIdx.x);
        pg8::EpiBf16<0> E{F.PR, NPAD, nullptr, 0, 0, 1.f};
        pg8::gemm_phase<pg8::EpiBf16<0>, pg8::StaticOrder, true, true>(F.lds, g, S, E);
        SEAM(1);
    }
    if (IN(2)) { ph_f1(F); ph_gla(F); SEAM(2); }
    if (IN(3)) { ph_f2(F); ph_mixbuild(F); SEAM(3); }
    if (IN(4)) {
        pg8::Gemm g{F.MIX, F.WOUT, M, DM, DM}; pg8::StaticOrder S; S.init(M, DM, F.G, (int)blockIdx.x);
        pg8::EpiResF32 E{F.x, F.out, DM, DN_ALPHA};
        pg8::gemm_phase<pg8::EpiResF32, pg8::StaticOrder, true, true>(F.lds, g, S, E);
        SEAM(4);
    }
    if (IN(5)) {
        bool bad = (__hip_atomic_load(F.ctl + CW_TMO, RLX_AGENT) != 0u);
        for (int li = 0; li < 3; ++li) bad |= __hip_atomic_load((gu32*)((const unsigned*)(F.ctl + CW_BAR) + XB_TMO) + li * XCD_BAR_WORDS, RLX_AGENT) != 0u;
        ph_ln(F, bad);
    }
#undef IN
#undef SEAM
}

extern "C" void kernel_launch(void* const* d_in, const int* in_sizes, int n_in, void* d_out, int out_size, void* d_ws, size_t ws_size, hipStream_t stream) {
    static int grid = 0;
    if (grid == 0) {
        if (n_in != 11 || in_sizes[0] != M * DM || out_size != M * DM || ws_size < WS_END) { fprintf(stderr, "kernel_launch: unexpected shapes: n_in %d in0 %d out %d ws %zu (need %zu)\n", n_in, n_in > 0 ? in_sizes[0] : -1, out_size, ws_size, (size_t)WS_END); grid = -1; return; }
        int dev = 0, cus = 0, per_cu = 0;
        if (hipGetDevice(&dev) != hipSuccess || hipDeviceGetAttribute(&cus, hipDeviceAttributeMultiprocessorCount, dev) != hipSuccess) { grid = -1; return; }
        if (hipFuncSetAttribute((const void*)fwd_kernel, hipFuncAttributeMaxDynamicSharedMemorySize, LDS_BYTES) != hipSuccess) { fprintf(stderr, "kernel_launch: hipFuncSetAttribute failed\n"); grid = -1; return; }
        if (hipOccupancyMaxActiveBlocksPerMultiprocessor(&per_cu, (const void*)fwd_kernel, NWAVES * 64, LDS_BYTES) != hipSuccess || per_cu < 1) { fprintf(stderr, "kernel_launch: occupancy query says %d blocks/CU\n", per_cu); per_cu = 1; }
        (void)hipGetLastError();
        grid = cus;
        if (grid > 256) grid = 256;
    }
    if (grid < 0) return;
    if (hipMemsetAsync((char*)d_ws + WS_CTL, 0, CTL_ZERO_BYTES, stream) != hipSuccess) { fprintf(stderr, "kernel_launch: memset failed\n"); return; }
    Args a{};
    for (int i = 0; i < 11; ++i) a.in[i] = (const float*)d_in[i];
    a.out = (float*)d_out; a.ws = (unsigned char*)d_ws;
    constexpr int NL = MK_N_LAUNCHES;
    for (int li = 0; li < NL; ++li) {
        if (NL == 1) { a.ph_lo = 0; a.ph_hi = N_PHASES; } else { a.ph_lo = li; a.ph_hi = li + 1; }
        a.li = (NL == 1) ? 0 : 0;
        hipLaunchKernelGGL(fwd_kernel, dim3(grid), dim3(NWAVES * 64), LDS_BYTES, stream, a);
        const hipError_t le = hipPeekAtLastError();
        if (le != hipSuccess) { fprintf(stderr, "kernel_launch: launch %d failed: %s\n", li, hipGetErrorName(le)); break; }
    }
}
```
